# Optimizing an MI355X kernel written in HIP

```python
import math
import jax, jax.numpy as jnp
from jax import lax
import numpy as np

D_MODEL = 2048
BATCH = 4
SEQ = 4096
DEPTH = 1

HEAD_DIM = 128
ATTN_WIDTH = 3 * D_MODEL // 4
N_ATTN_HEADS = ATTN_WIDTH // HEAD_DIM
GMLP_WIDTH = D_MODEL // 4
GMLP_GROUP_WIDTH = 128
GMLP_GROUPS = GMLP_WIDTH // GMLP_GROUP_WIDTH
GMLP_CHUNK = 128
MIX_WIDTH = ATTN_WIDTH + GMLP_WIDTH
IN_PROJ_WIDTH = 3 * ATTN_WIDTH + 2 * GMLP_WIDTH
DILATED_PAIRS = ((128, 1), (512, 4), (2048, 16))
ATTN_BLOCK = 128
ROPE_THETA = 10000.0

N_EXPERTS = 32
TOP_K = 4
D_FF = D_MODEL
SWIGLU_LIMIT = 7.0
SWIGLU_ALPHA = 1.702
MOE_BLOCK = 128

DEEPNORM_ALPHA = (2 * DEPTH) ** 0.25
DEEPNORM_BETA = (8 * DEPTH) ** -0.25
LN_EPS = 1e-5
NEG_INF = -1e30

kernel_name = "hybrid_dilated_attn_gmlp_moe_deepnorm_adaln"


def layer_norm(x, g=None, b=None):
    xf = x.astype(jnp.float32)
    mu = jnp.mean(xf, axis=-1, keepdims=True)
    xc = xf - mu
    y = xc * lax.rsqrt(jnp.mean(xc * xc, axis=-1, keepdims=True) + LN_EPS)
    if g is not None:
        y = y * g.astype(jnp.float32) + b.astype(jnp.float32)
    return y.astype(x.dtype)


def rope(x, positions):
    half = HEAD_DIM // 2
    inv_freq = jnp.power(ROPE_THETA, -jnp.arange(half, dtype=jnp.float32) * (2.0 / HEAD_DIM))
    ang = positions.astype(jnp.float32)[:, :, None] * inv_freq
    cos = jnp.cos(ang)[:, :, None, :]
    sin = jnp.sin(ang)[:, :, None, :]
    xf = x.astype(jnp.float32)
    x1, x2 = xf[..., :half], xf[..., half:]
    return jnp.concatenate([x1 * cos - x2 * sin, x2 * cos + x1 * sin], axis=-1).astype(x.dtype)


def dilated_branch(q, k, v, window, dil):
    B, H, S, hd = q.shape
    max_rel = window // dil
    assert max_rel <= ATTN_BLOCK
    L = S // dil
    nb = -(-L // ATTN_BLOCK)
    pad = nb * ATTN_BLOCK - L

    def strided(a):
        return a.reshape(B, H, L, dil, hd).transpose(0, 1, 3, 2, 4)

    qs, ks, vs = strided(q), strided(k), strided(v)
    qs = jnp.pad(qs, ((0, 0), (0, 0), (0, 0), (0, pad), (0, 0)))
    kpad = ((0, 0), (0, 0), (0, 0), (ATTN_BLOCK, pad), (0, 0))
    ks = jnp.pad(ks, kpad).reshape(B, H, dil, nb + 1, ATTN_BLOCK, hd)
    vs = jnp.pad(vs, kpad).reshape(B, H, dil, nb + 1, ATTN_BLOCK, hd)
    qb = qs.reshape(B, H, dil, nb, ATTN_BLOCK, hd)
    kw = jnp.concatenate([ks[:, :, :, :-1], ks[:, :, :, 1:]], axis=-2)
    vw = jnp.concatenate([vs[:, :, :, :-1], vs[:, :, :, 1:]], axis=-2)

    logits = jnp.einsum('bhrnqd,bhrnkd->bhrnqk', qb, kw,
                        preferred_element_type=jnp.float32) * (1.0 / math.sqrt(HEAD_DIM))
    qi = jnp.arange(ATTN_BLOCK)[:, None]
    ki = jnp.arange(2 * ATTN_BLOCK)[None, :]
    dist = qi - ki + ATTN_BLOCK
    rel_ok = (dist >= 0) & (dist <= max_rel)
    key_pos = jnp.arange(nb)[:, None, None] * ATTN_BLOCK + ki[None] - ATTN_BLOCK
    mask = rel_ok[None] & (key_pos >= 0)
    logits = jnp.where(mask, logits, NEG_INF)
    lse = jax.nn.logsumexp(logits, axis=-1)
    p = jnp.exp(logits - lse[..., None])
    o = jnp.einsum('bhrnqk,bhrnkd->bhrnqd', p.astype(v.dtype), vw,
                   preferred_element_type=jnp.float32)
    o = o.reshape(B, H, dil, nb * ATTN_BLOCK, hd)[:, :, :, :L]
    o = o.transpose(0, 1, 3, 2, 4).reshape(B, H, S, hd)
    lse = lse.reshape(B, H, dil, nb * ATTN_BLOCK)[:, :, :, :L].transpose(0, 1, 3, 2).reshape(B, H, S)
    return o, lse


def hybrid_mixer(h, positions, w_in, w_spatial, b_spatial, gmlp_ln_g, gmlp_ln_b, w_out):
    B, S, _ = h.shape
    proj = h @ w_in
    A, G = ATTN_WIDTH, GMLP_WIDTH
    q, k, v, u, vg = jnp.split(proj, [A, 2 * A, 3 * A, 3 * A + G], axis=-1)

    q = rope(q.reshape(B, S, N_ATTN_HEADS, HEAD_DIM), positions).transpose(0, 2, 1, 3)
    k = rope(k.reshape(B, S, N_ATTN_HEADS, HEAD_DIM), positions).transpose(0, 2, 1, 3)
    v = v.reshape(B, S, N_ATTN_HEADS, HEAD_DIM).transpose(0, 2, 1, 3)
    outs, lses = zip(*[dilated_branch(q, k, v, w, d) for (w, d) in DILATED_PAIRS])
    mix_w = jax.nn.softmax(jnp.stack(lses), axis=0)
    attn = jnp.einsum('rbhs,rbhsd->bshd', mix_w, jnp.stack(outs)).reshape(B, S, A).astype(h.dtype)

    u = jax.nn.gelu(u, approximate=False)
    vg = layer_norm(jax.nn.gelu(vg, approximate=False), gmlp_ln_g, gmlp_ln_b)
    nc = S // GMLP_CHUNK
    vg = vg.reshape(B, nc, GMLP_CHUNK, GMLP_GROUPS, GMLP_GROUP_WIDTH)
    causal = jnp.tril(jnp.ones((GMLP_CHUNK, GMLP_CHUNK), dtype=bool))
    ws = jnp.where(causal[None], w_spatial, 0.0).astype(vg.dtype)
    spatial = jnp.einsum('gts,bnsgc->bntgc', ws, vg) + b_spatial.T[None, None, :, :, None]
    gm = (u.reshape(B, nc, GMLP_CHUNK, GMLP_GROUPS, GMLP_GROUP_WIDTH) * spatial).reshape(B, S, G)

    return jnp.concatenate([attn, gm.astype(h.dtype)], axis=-1) @ w_out


def moe_ffn(h, router_w, router_b, w_gate_up, b_gate_up, w_down, b_down):
    B, S, D = h.shape
    T = B * S
    xs = h.reshape(T, D)
    logits = (xs @ router_w + router_b).astype(jnp.float32)
    top_logits, top_idx = lax.top_k(logits, TOP_K)
    gates = jax.nn.softmax(top_logits, axis=-1)

    n_assign = T * TOP_K
    expert_of = top_idx.reshape(n_assign)
    token_of = jnp.repeat(jnp.arange(T, dtype=jnp.int32), TOP_K)
    gate_of = gates.reshape(n_assign)
    order = jnp.argsort(expert_of)
    e_sorted = expert_of[order]
    counts = jnp.bincount(expert_of, length=N_EXPERTS)
    starts = jnp.cumsum(counts) - counts
    padded = (counts + MOE_BLOCK - 1) // MOE_BLOCK * MOE_BLOCK
    pad_end = jnp.cumsum(padded)
    pad_start = pad_end - padded
    slot = pad_start[e_sorted] + jnp.arange(n_assign) - starts[e_sorted]
    n_slots = (-(-n_assign // MOE_BLOCK) + N_EXPERTS) * MOE_BLOCK
    n_blocks = n_slots // MOE_BLOCK
    slot_token = jnp.zeros((n_slots,), jnp.int32).at[slot].set(token_of[order])
    slot_gate = jnp.zeros((n_slots,), jnp.float32).at[slot].set(gate_of[order])
    block_expert = jnp.minimum(
        jnp.searchsorted(pad_end, jnp.arange(n_blocks) * MOE_BLOCK, side='right'), N_EXPERTS - 1)
    x_blocks = xs[slot_token].reshape(n_blocks, MOE_BLOCK, D)

    def expert_block(args):
        xb, e = args
        gu = (xb @ w_gate_up[e] + b_gate_up[e]).astype(jnp.float32)
        gate, up = gu[:, :D_FF], gu[:, D_FF:]
        gate = jnp.minimum(gate, SWIGLU_LIMIT)
        up = jnp.clip(up, -SWIGLU_LIMIT, SWIGLU_LIMIT)
        act = ((up + 1.0) * (gate * jax.nn.sigmoid(gate * SWIGLU_ALPHA))).astype(xb.dtype)
        return act @ w_down[e] + b_down[e]

    y_blocks = lax.map(expert_block, (x_blocks, block_expert))
    y = jnp.zeros((T, D), jnp.float32).at[slot_token].add(
        y_blocks.reshape(n_slots, D).astype(jnp.float32) * slot_gate[:, None])
    return y.reshape(B, S, D).astype(h.dtype)


def setup_inputs(seed: int = 0) -> dict:
    key = jax.random.key(seed)
    ks = jax.random.split(key, 22)
    f32 = jnp.float32
    nrm = lambda k, shape, s: jax.random.normal(k, shape, f32) * s
    L = DEPTH
    x = jax.random.normal(ks[0], (BATCH, SEQ, D_MODEL), f32)
    c = jax.random.normal(ks[1], (BATCH, D_MODEL), f32)
    positions = (jnp.arange(SEQ, dtype=jnp.int32)[None, :]
                 + jax.random.randint(ks[2], (BATCH, 1), 0, 1024, dtype=jnp.int32))
    return {
        "x": x,
        "c": c,
        "positions": positions,
        "ada_w": nrm(ks[3], (L, D_MODEL, 6 * D_MODEL), D_MODEL ** -0.5),
        "ada_b": nrm(ks[4], (L, 6 * D_MODEL), 0.02),
        "w_in": nrm(ks[5], (L, D_MODEL, IN_PROJ_WIDTH), D_MODEL ** -0.5),
        "w_spatial": nrm(ks[6], (L, GMLP_GROUPS, GMLP_CHUNK, GMLP_CHUNK), GMLP_CHUNK ** -0.5),
        "b_spatial": 1.0 + nrm(ks[7], (L, GMLP_GROUPS, GMLP_CHUNK), 0.1),
        "gmlp_ln_g": 1.0 + nrm(ks[8], (L, GMLP_WIDTH), 0.05),
        "gmlp_ln_b": nrm(ks[9], (L, GMLP_WIDTH), 0.02),
        "w_out": nrm(ks[10], (L, MIX_WIDTH, D_MODEL), DEEPNORM_BETA * MIX_WIDTH ** -0.5),
        "ln1_g": 1.0 + nrm(ks[11], (L, D_MODEL), 0.05),
        "ln1_b": nrm(ks[12], (L, D_MODEL), 0.02),
        "router_w": nrm(ks[13], (L, D_MODEL, N_EXPERTS), D_MODEL ** -0.5),
        "router_b": nrm(ks[14], (L, N_EXPERTS), 0.01),
        "w_gate_up": nrm(ks[15], (L, N_EXPERTS, D_MODEL, 2 * D_FF), D_MODEL ** -0.5),
        "b_gate_up": nrm(ks[16], (L, N_EXPERTS, 2 * D_FF), 0.01),
        "w_down": nrm(ks[17], (L, N_EXPERTS, D_FF, D_MODEL), DEEPNORM_BETA * D_FF ** -0.5),
        "b_down": nrm(ks[18], (L, N_EXPERTS, D_MODEL), 0.01),
        "ln2_g": 1.0 + nrm(ks[19], (L, D_MODEL), 0.05),
        "ln2_b": nrm(ks[20], (L, D_MODEL), 0.02),
    }


def reference(x, c, positions, ada_w, ada_b, w_in, w_spatial, b_spatial, gmlp_ln_g, gmlp_ln_b,
              w_out, ln1_g, ln1_b, router_w, router_b, w_gate_up, b_gate_up, w_down, b_down,
              ln2_g, ln2_b):
    for l in range(DEPTH):
        mod = (jax.nn.silu(c) @ ada_w[l] + ada_b[l])[:, None, :]
        sh1, sc1, g1, sh2, sc2, g2 = jnp.split(mod, 6, axis=-1)

        h = layer_norm(x) * (1.0 + sc1) + sh1
        mix = hybrid_mixer(h, positions, w_in[l], w_spatial[l], b_spatial[l],
                           gmlp_ln_g[l], gmlp_ln_b[l], w_out[l])
        x = layer_norm(DEEPNORM_ALPHA * x + g1 * mix, ln1_g[l], ln1_b[l])

        h = layer_norm(x) * (1.0 + sc2) + sh2
        ffn = moe_ffn(h, router_w[l], router_b[l], w_gate_up[l], b_gate_up[l], w_down[l], b_down[l])
        x = layer_norm(DEEPNORM_ALPHA * x + g2 * ffn, ln2_g[l], ln2_b[l])
    return x
```

```cpp
#include <hip/hip_runtime.h>
#include <cstdio>
#include <cstdint>

#ifndef MK_N_LAUNCHES
#define MK_N_LAUNCHES 1
#endif

constexpr int BATCH = 4, SEQ = 4096, T = BATCH * SEQ, D = 2048;
constexpr int AW = 1536, NH = 12, HD = 128, GW = 512, NPROJ = 3 * AW + 2 * GW;
constexpr int NE = 32, TOPK = 4, DFF = 2048;
constexpr int MAXTILES = T * TOPK / 256 + NE;
constexpr float LN_EPS = 1e-5f;
constexpr float DN_ALPHA = 1.189207115002721f;
constexpr float QSCALE = 0.08838834764831845f * 1.4426950408889634f;

namespace pg8 {
#define PG8_LAS __attribute__((address_space(3)))
typedef unsigned short bf16_t;
typedef short bf16x8 __attribute__((ext_vector_type(8)));
typedef float f32x4 __attribute__((ext_vector_type(4)));
typedef float f32x2 __attribute__((ext_vector_type(2)));
typedef unsigned u32x4 __attribute__((ext_vector_type(4)));
constexpr int BM = 256, BK = 64, HALF = 128, HTB = HALF * BK * 2, STAGE_BYTES = 8 * HTB, NXCD = 8, WGM = 4;

__host__ __device__ __forceinline__ int lds_byte(int r, int c) { const int st = (r >> 4) * 2 + (c >> 5), rr = r & 15, cc = c & 31, ob = rr * 64 + cc * 2; return st * 1024 + (ob ^ (((ob >> 9) & 1) << 5)); }
__host__ __device__ __forceinline__ void stage_rc(int b, int& R, int& C) { const int st = b / 1024, sb = b % 1024, swz = sb ^ (((sb >> 9) & 1) << 5); R = (st >> 1) * 16 + swz / 64; C = (st & 1) * 32 + (swz % 64) / 2; }
__host__ __device__ __forceinline__ int perm32(int rho) { const int n = rho >> 4, i = rho & 15; return 8 * (i >> 2) + 4 * n + (i & 3); }

struct Unit { int pm, pn, e; };
struct Gemm { const void* A; const void* Bt; int rowbytes; size_t bstride; const int* rowidx; const float* rowscale = nullptr; const float* splitratio = nullptr; int split_t = -1; };
typedef int v8i_t __attribute__((ext_vector_type(8)));
typedef int v4i_t __attribute__((ext_vector_type(4)));

struct Order {
    int nM, nN, nwg, G, c, wgm, gap_at = 0x7fffffff, gap = 0; const int* tile_e;
    __device__ void init(int nM_, int nN_, int G_, int c_, const int* te, int wgm_) { nM = nM_; nN = nN_; nwg = nM * nN; G = G_; c = c_; tile_e = te; wgm = wgm_; }
    __device__ bool next(int i, Unit& u) const {
        const long L = (long)i * G + c; if (L >= nwg) return false;
        int wgid = (int)L; { const int q = nwg / NXCD, r = nwg % NXCD, xcd = wgid % NXCD, off = wgid / NXCD; wgid = (xcd < r ? xcd * (q + 1) : r * (q + 1) + (xcd - r) * q) + off; }
        const int nig = wgm * nN, gid = wgid / nig, fm = gid * wgm, gsz = (nM - fm) < wgm ? (nM - fm) : wgm;
        u.pm = fm + ((wgid % nig) % gsz); u.pn = (wgid % nig) / gsz; if (u.pn >= gap_at) u.pn += gap; u.e = tile_e ? tile_e[u.pm] : 0; return true;
    }
};

__device__ __forceinline__ unsigned cvt_pk_bf16(float lo, float hi) { unsigned r; asm volatile("v_cvt_pk_bf16_f32 %0, %1, %2" : "=v"(r) : "v"(lo), "v"(hi)); return r; }
__device__ __forceinline__ f32x2 gelu_pk(f32x2 v) {
    const f32x2 av = __builtin_elementwise_abs(v), d = av * 0.2316418882f + 1.0f;
    f32x2 t; t.x = __builtin_amdgcn_rcpf(d.x); t.y = __builtin_amdgcn_rcpf(d.y);
    f32x2 q = t * 0.5307027145f + (-0.7265760135f); q = q * t + 0.7107068705f; q = q * t + (-0.142248368f); q = q * t + 0.127414796f; q = q * t;
    const f32x2 s = (v * v) * (-0.72134752044f);
    f32x2 e; e.x = __builtin_amdgcn_exp2f(s.x); e.y = __builtin_amdgcn_exp2f(s.y);
    const f32x2 m = v * (q * e), r = v - m;
    f32x2 o; o.x = v.x < 0.f ? m.x : r.x; o.y = v.y < 0.f ? m.y : r.y; return o;
}
__device__ __forceinline__ f32x4 gelu4(f32x4 v) { const f32x2 a = gelu_pk((f32x2){v[0], v[1]}), b = gelu_pk((f32x2){v[2], v[3]}); return (f32x4){a.x, a.y, b.x, b.y}; }
__device__ __forceinline__ u32x4 pack8(f32x4 v0, f32x4 v1) { u32x4 w; w.x = cvt_pk_bf16(v0[0], v0[1]); w.y = cvt_pk_bf16(v0[2], v0[3]); w.z = cvt_pk_bf16(v1[0], v1[1]); w.w = cvt_pk_bf16(v1[2], v1[3]); return w; }

struct EpiInProj {
    static constexpr bool PERM = true;
    unsigned char* ws; size_t off_q, off_u; const _Float16* rope; float descale;
    __device__ __forceinline__ void operator()(const f32x4 (&acc)[2][2][4][2], const Unit& u, int wr, int wc, int fr, int fq) const {
        const int row0 = u.pm * BM + wr * 64 + fr, pn = u.pn;
        if (pn < 12) {
            const int tq = pn >= 6 ? 1 : 0;
            bf16_t* dst = (bf16_t*)(ws + off_q + (size_t)tq * (48u << 20)); const float sc = (tq ? 1.0f : QSCALE) * descale;
            const int i0 = 32 * (wc & 1) + 8 * fq, col = (pn - 6 * tq) * 256 + (wc >> 1) * 128 + i0;
            typedef _Float16 h16x8 __attribute__((ext_vector_type(8)));
            h16x8 cs[2][4][2];
#pragma unroll
            for (int ai = 0; ai < 2; ++ai)
#pragma unroll
                for (int m = 0; m < 4; ++m) { const h16x8* p = (const h16x8*)(rope + ((size_t)(row0 + ai * HALF + m * 16) * 64 + i0) * 2); cs[ai][m][0] = p[0]; cs[ai][m][1] = p[1]; }
#pragma unroll
            for (int ai = 0; ai < 2; ++ai)
#pragma unroll
                for (int m = 0; m < 4; ++m) {
                    const int row = row0 + ai * HALF + m * 16;
                    f32x4 o1[2], o2[2];
#pragma unroll
                    for (int n = 0; n < 2; ++n) { const f32x4 av = acc[ai][0][m][n], bv = acc[ai][1][m][n]; const h16x8 c = cs[ai][m][n];
#pragma unroll
                        for (int j = 0; j < 4; ++j) { const float cc = (float)c[2 * j], ss = (float)c[2 * j + 1];
                            o1[n][j] = (av[j] * cc - bv[j] * ss) * sc; o2[n][j] = (bv[j] * cc + av[j] * ss) * sc; } }
                    bf16_t* p = dst + (size_t)row * AW + col;
                    *(u32x4*)p = pack8(o1[0], o1[1]); *(u32x4*)(p + 64) = pack8(o2[0], o2[1]);
                }
        } else if (pn < 18) {
            bf16_t* dst = (bf16_t*)(ws + off_q + (size_t)2 * (48u << 20));
            const int col = (pn - 12) * 256 + wc * 32 + 8 * fq;
#pragma unroll
            for (int ai = 0; ai < 2; ++ai)
#pragma unroll
                for (int m = 0; m < 4; ++m) { bf16_t* rowp = dst + (size_t)(row0 + ai * HALF + m * 16) * AW + col;
#pragma unroll
                    for (int bj = 0; bj < 2; ++bj) *(u32x4*)(rowp + bj * HALF) = pack8(acc[ai][bj][m][0] * descale, acc[ai][bj][m][1] * descale); }
        } else {
            const int tu = (pn - 18) >> 1;
            bf16_t* dst = (bf16_t*)(ws + off_u + (size_t)tu * (16u << 20));
            const int col = ((pn - 18) & 1) * 256 + wc * 32 + 8 * fq;
#pragma unroll
            for (int ai = 0; ai < 2; ++ai)
#pragma unroll
                for (int m = 0; m < 4; ++m) { bf16_t* rowp = dst + (size_t)(row0 + ai * HALF + m * 16) * GW + col;
#pragma unroll
                    for (int bj = 0; bj < 2; ++bj) *(u32x4*)(rowp + bj * HALF) = pack8(gelu4(acc[ai][bj][m][0] * descale), gelu4(acc[ai][bj][m][1] * descale)); }
        }
    }
};
struct EpiOutProj {
    static constexpr bool PERM = true;
    const float* x; const float* mod; bf16_t* Y; float descale;
    __device__ __forceinline__ void operator()(const f32x4 (&acc)[2][2][4][2], const Unit& u, int wr, int wc, int fr, int fq) const {
        const int row0 = u.pm * BM + wr * 64 + fr, col0 = u.pn * BM + wc * 32 + 8 * fq;
        const float* g1 = mod + (size_t)(u.pm / (SEQ / BM)) * (6 * D) + 2 * D;
        f32x4 gv[2][2];
#pragma unroll
        for (int bj = 0; bj < 2; ++bj)
#pragma unroll
            for (int n = 0; n < 2; ++n) gv[bj][n] = *(const f32x4*)(g1 + col0 + bj * HALF + n * 4) * descale;
#pragma unroll
        for (int ai = 0; ai < 2; ++ai) {
            f32x4 xv[4][2][2];
#pragma unroll
            for (int m = 0; m < 4; ++m) { const size_t off = (size_t)(row0 + ai * HALF + m * 16) * D + col0;
#pragma unroll
                for (int bj = 0; bj < 2; ++bj)
#pragma unroll
                    for (int n = 0; n < 2; ++n) xv[m][bj][n] = *(const f32x4*)(x + off + bj * HALF + n * 4); }
#pragma unroll
            for (int m = 0; m < 4; ++m) { const size_t off = (size_t)(row0 + ai * HALF + m * 16) * D + col0;
#pragma unroll
                for (int bj = 0; bj < 2; ++bj)
                    *(u32x4*)(Y + off + bj * HALF) = pack8(xv[m][bj][0] * DN_ALPHA + gv[bj][0] * acc[ai][bj][m][0], xv[m][bj][1] * DN_ALPHA + gv[bj][1] * acc[ai][bj][m][1]); }
            asm volatile("" ::: "memory");
        }
    }
};
struct EpiSwiglu {
    static constexpr bool PERM = true;
    const float* bgu; unsigned char* ACT; float descale, oscale;
    __device__ __forceinline__ void operator()(const f32x4 (&acc)[2][2][4][2], const Unit& u, int wr, int wc, int fr, int fq) const {
        const int row0 = u.pm * BM + wr * 64 + fr, col = u.pn * 128 + wc * 32 + 8 * fq;
        const float* bg = bgu + (size_t)u.e * (2 * DFF) + col;
        const f32x4 g0 = *(const f32x4*)bg, g1 = *(const f32x4*)(bg + 4), u0 = *(const f32x4*)(bg + DFF), u1 = *(const f32x4*)(bg + DFF + 4);
#pragma unroll
        for (int ai = 0; ai < 2; ++ai)
#pragma unroll
            for (int m = 0; m < 4; ++m) {
                f32x4 o[2];
#pragma unroll
                for (int n = 0; n < 2; ++n) {
                    const f32x4 gt = acc[ai][0][m][n] * descale + (n ? g1 : g0), up = acc[ai][1][m][n] * descale + (n ? u1 : u0);
#pragma unroll
                    for (int j = 0; j < 4; ++j) { const float g = fminf(gt[j], 7.0f), uu = fminf(fmaxf(up[j], -7.0f), 7.0f);
                        const float sg = __builtin_amdgcn_rcpf(1.0f + __builtin_amdgcn_exp2f(g * (-1.702f * 1.4426950408889634f)));
                        o[n][j] = (uu + 1.0f) * (g * sg) * oscale; }
                }
                f32x2 w; { int w0 = __builtin_amdgcn_cvt_pk_fp8_f32(o[0][0], o[0][1], 0, false); w0 = __builtin_amdgcn_cvt_pk_fp8_f32(o[0][2], o[0][3], w0, true);
                    int w1 = __builtin_amdgcn_cvt_pk_fp8_f32(o[1][0], o[1][1], 0, false); w1 = __builtin_amdgcn_cvt_pk_fp8_f32(o[1][2], o[1][3], w1, true); w.x = __builtin_bit_cast(float, w0); w.y = __builtin_bit_cast(float, w1); }
                *(f32x2*)(ACT + (size_t)(row0 + ai * HALF + m * 16) * DFF + col) = w;
            }
    }
};
struct EpiDown {
    static constexpr bool PERM = true;
    const float* bd; unsigned char* YS; float descale, oscale;
    __device__ __forceinline__ void operator()(const f32x4 (&acc)[2][2][4][2], const Unit& u, int wr, int wc, int fr, int fq) const {
        const int row0 = u.pm * BM + wr * 64 + fr, col0 = u.pn * BM + wc * 32 + 8 * fq;
        const float* b = bd + (size_t)u.e * D + col0;
        f32x4 bv[2][2];
#pragma unroll
        for (int bj = 0; bj < 2; ++bj)
#pragma unroll
            for (int n = 0; n < 2; ++n) bv[bj][n] = *(const f32x4*)(b + bj * HALF + 4 * n) * oscale;
        const float ds = descale * oscale;
#pragma unroll
        for (int ai = 0; ai < 2; ++ai)
#pragma unroll
            for (int m = 0; m < 4; ++m) { unsigned char* rowp = YS + (size_t)(row0 + ai * HALF + m * 16) * D + col0;
#pragma unroll
                for (int bj = 0; bj < 2; ++bj) {
                    f32x4 o0 = acc[ai][bj][m][0] * ds + bv[bj][0], o1 = acc[ai][bj][m][1] * ds + bv[bj][1];
#pragma unroll
                    for (int j = 0; j < 4; ++j) { o0[j] = fminf(fmaxf(o0[j], -448.0f), 448.0f); o1[j] = fminf(fmaxf(o1[j], -448.0f), 448.0f); }
                    int w0 = __builtin_amdgcn_cvt_pk_fp8_f32(o0[0], o0[1], 0, false); w0 = __builtin_amdgcn_cvt_pk_fp8_f32(o0[2], o0[3], w0, true);
                    int w1 = __builtin_amdgcn_cvt_pk_fp8_f32(o1[0], o1[1], 0, false); w1 = __builtin_amdgcn_cvt_pk_fp8_f32(o1[2], o1[3], w1, true);
                    f32x2 w; w.x = __builtin_bit_cast(float, w0); w.y = __builtin_bit_cast(float, w1);
                    *(f32x2*)(rowp + bj * HALF) = w; }
            }
    }
};

__device__ __forceinline__ void glds2(unsigned voff0, const void* sbase0, unsigned voff1, const void* sbase1, unsigned lds_dst) {
    unsigned keep; const unsigned lds_dst1 = lds_dst + 8192u;
    asm volatile("s_mov_b32 %0, m0\n\ts_mov_b32 m0, %5\n\ts_nop 0\n\tglobal_load_lds_dwordx4 %1, %2\n\ts_mov_b32 m0, %6\n\ts_nop 0\n\tglobal_load_lds_dwordx4 %3, %4\n\ts_mov_b32 m0, %0"
                 : "=&s"(keep) : "v"(voff0), "s"(sbase0), "v"(voff1), "s"(sbase1), "s"(lds_dst), "s"(lds_dst1) : "memory");
}
template <class Epi, bool GATHER, int MODE, bool SPLIT = false>
__device__ __forceinline__ void gemm_phase(PG8_LAS unsigned char* lds, const Gemm g, const Order& S, const Epi& E) {
    int tid_ = threadIdx.x; asm volatile("" : "+v"(tid_));
    const int tid = tid_, wid = __builtin_amdgcn_readfirstlane(tid >> 6), lane = tid & 63, wr = wid >> 2, wc = wid & 3, fr = lane & 15, fq = lane >> 4;
    const int RB = g.rowbytes, nt = RB / 128;
    int R0, C0; stage_rc(tid * 16, R0, C0);
    const int Rb0 = Epi::PERM ? ((R0 & ~31) + perm32(R0 & 31)) : R0;
    const unsigned voffB = (unsigned)(Rb0 * RB + C0 * 2), voffA = (unsigned)(R0 * RB + C0 * 2);
    const size_t kstep = (size_t)(BK * 2);
    const size_t qstep = (size_t)64 * RB;
    const size_t hstep = (size_t)HALF * RB;
    const size_t tstep = 2 * hstep;
    const unsigned ldsb = (unsigned)(size_t)lds + (unsigned)wid * 1024u;
    const int aoff = lds_byte(wr * 64 + fr, fq * 8), boff = lds_byte(wc * 32 + fr, fq * 8);
#define PG8_SA(b, h) (((b) * 2 + (h)) * HTB)
#define PG8_SB(b, h) ((4 + (b) * 2 + (h)) * HTB)
#define PG8_STAGEB(bufoff, gbase) glds2(voffB, (gbase), voffB, (gbase) + qstep, ldsb + (bufoff))
#define PG8_STAGEA(bufoff, rowb, v, h, kb) do { if constexpr (GATHER) glds2((v)[h][0], Ab + (kb), (v)[h][1], Ab + (kb), ldsb + (bufoff)); \
        else glds2(voffA, Ab + (rowb) + (h) * hstep + (kb), voffA, Ab + (rowb) + (h) * hstep + qstep + (kb), ldsb + (bufoff)); } while (0)
#define PG8_LDA(dst, b, h) do { _Pragma("unroll") for (int m = 0; m < 4; ++m) _Pragma("unroll") for (int k = 0; k < 2; ++k) dst[m][k] = *(const PG8_LAS bf16x8*)(lds + PG8_SA(b, h) + aoff + m * 2048 + k * 1024); } while (0)
#define PG8_LDB(dst, b, h) do { _Pragma("unroll") for (int n = 0; n < 2; ++n) _Pragma("unroll") for (int k = 0; k < 2; ++k) dst[n][k] = *(const PG8_LAS bf16x8*)(lds + PG8_SB(b, h) + boff + n * 2048 + k * 1024); } while (0)
#define PG8_MMA(ai, bj, At, Bt) do { __builtin_amdgcn_s_setprio(1); \
        if constexpr (MODE == 1) { _Pragma("unroll") for (int m = 0; m < 4; ++m) _Pragma("unroll") for (int n = 0; n < 2; ++n) { \
            const v8i_t b8 = __builtin_shufflevector(__builtin_bit_cast(v4i_t, Bt[n][0]), __builtin_bit_cast(v4i_t, Bt[n][1]), 0, 1, 2, 3, 4, 5, 6, 7); \
            const v8i_t a8 = __builtin_shufflevector(__builtin_bit_cast(v4i_t, At[m][0]), __builtin_bit_cast(v4i_t, At[m][1]), 0, 1, 2, 3, 4, 5, 6, 7); \
            asm volatile("v_mfma_f32_16x16x128_f8f6f4 %0, %1, %2, %0" : "+v"(acc[ai][bj][m][n]) : "v"(b8), "v"(a8)); } } \
        else if constexpr (MODE == 2) { _Pragma("unroll") for (int k = 0; k < 2; ++k) _Pragma("unroll") for (int m = 0; m < 4; ++m) _Pragma("unroll") for (int n = 0; n < 2; ++n) \
            asm volatile("v_mfma_i32_16x16x64_i8 %0, %1, %2, %0" : "+v"(acc[ai][bj][m][n]) : "v"(Bt[n][k]), "v"(At[m][k])); } \
        else { _Pragma("unroll") for (int m = 0; m < 4; ++m) _Pragma("unroll") for (int n = 0; n < 2; ++n) _Pragma("unroll") for (int k = 0; k < 2; ++k) \
            acc[ai][bj][m][n] = __builtin_amdgcn_mfma_f32_16x16x32_bf16(Bt[n][k], At[m][k], acc[ai][bj][m][n], 0, 0, 0); } \
        __builtin_amdgcn_s_setprio(0); } while (0)
#define PG8_WAIT_V(n) asm volatile("s_waitcnt vmcnt(" #n ")" ::: "memory")
#define PG8_WAIT_L(n) asm volatile("s_waitcnt lgkmcnt(" #n ")" ::: "memory")
#define PG8_BAR __builtin_amdgcn_s_barrier()
#define PG8_SCHED __builtin_amdgcn_sched_barrier(0)
#define PG8_VOFF(dst, U) do { if constexpr (GATHER) { _Pragma("unroll") for (int h = 0; h < 2; ++h) _Pragma("unroll") for (int i = 0; i < 2; ++i) { \
        const int row = g.rowidx[(U).pm * BM + h * HALF + i * 64 + R0]; dst[h][i] = (unsigned)row * (unsigned)RB + (unsigned)C0 * 2u; } } } while (0)
    Unit cur, nxt; int ui = 0;
    if (!S.next(0, cur)) return;
    f32x4 acc[2][2][4][2];
#pragma unroll
    for (int a = 0; a < 2; ++a)
#pragma unroll
        for (int b = 0; b < 2; ++b)
#pragma unroll
            for (int m = 0; m < 4; ++m)
#pragma unroll
                for (int n = 0; n < 2; ++n) acc[a][b][m][n] = (f32x4){0.f, 0.f, 0.f, 0.f};
    bf16x8 At[4][2], B0[2][2], B1[2][2];
    unsigned cv[2][2] = {{0u, 0u}, {0u, 0u}}, nv[2][2] = {{0u, 0u}, {0u, 0u}};
    PG8_VOFF(cv, cur);
    const char* const Ab = (const char*)g.A;
    size_t cAr = (size_t)cur.pm * tstep;
    const char* cB = (const char*)g.Bt + (size_t)cur.e * g.bstride + (size_t)cur.pn * tstep;
    PG8_STAGEB(PG8_SB(0, 0), cB); PG8_STAGEB(PG8_SB(0, 1), cB + hstep); PG8_STAGEA(PG8_SA(0, 0), cAr, cv, 0, 0); PG8_STAGEA(PG8_SA(0, 1), cAr, cv, 1, 0);
    if (wr == 1) PG8_BAR;
    PG8_WAIT_V(2); PG8_BAR;
    PG8_STAGEB(PG8_SB(1, 0), cB + kstep); PG8_STAGEA(PG8_SA(1, 0), cAr, cv, 0, kstep); PG8_STAGEB(PG8_SB(1, 1), cB + hstep + kstep);
    PG8_WAIT_V(6); PG8_BAR;
    for (;;) {
        float rs2[2] = {0.f, 0.f};
        if constexpr (MODE == 2) {
#pragma unroll
            for (int a = 0; a < 2; ++a) rs2[a] = g.rowscale[cur.pm * BM + a * HALF + wr * 64 + fq * 16 + fr]; }
        const bool has_next = S.next(ui + 1, nxt);
        const char* nB = has_next ? (const char*)g.Bt + (size_t)nxt.e * g.bstride + (size_t)nxt.pn * tstep : cB;
        const size_t nAr = has_next ? (size_t)nxt.pm * tstep : cAr;
        if (has_next) { PG8_VOFF(nv, nxt); }
        else {
#pragma unroll
            for (int h = 0; h < 2; ++h)
#pragma unroll
                for (int i = 0; i < 2; ++i) nv[h][i] = cv[h][i]; }
        for (int t = 0; t < nt - 2; t += 2) {
            if constexpr (SPLIT) if (t == g.split_t) {
                asm volatile("s_nop 15\n\ts_nop 15" ::: "memory");
#pragma unroll
                for (int a = 0; a < 2; ++a)
#pragma unroll
                    for (int m = 0; m < 4; ++m) { const float rr = g.splitratio[cur.pm * BM + a * HALF + wr * 64 + m * 16 + fr];
#pragma unroll
                        for (int b = 0; b < 2; ++b)
#pragma unroll
                            for (int n = 0; n < 2; ++n) { const v4i_t iv = __builtin_bit_cast(v4i_t, acc[a][b][m][n]);
                                const v4i_t ov = {(int)__builtin_rintf((float)iv[0] * rr), (int)__builtin_rintf((float)iv[1] * rr), (int)__builtin_rintf((float)iv[2] * rr), (int)__builtin_rintf((float)iv[3] * rr)};
                                acc[a][b][m][n] = __builtin_bit_cast(f32x4, ov); } }
                asm volatile("s_nop 7" ::: "memory");
            }
            const size_t k1 = (size_t)(t + 1) * kstep, k2 = k1 + kstep, k3 = k2 + kstep;
            const char* b2 = cB + k2; const char* b3 = cB + k3;
            PG8_LDB(B0, 0, 0); PG8_LDB(B1, 0, 1); PG8_SCHED; PG8_LDA(At, 0, 0); PG8_STAGEA(PG8_SA(1, 1), cAr, cv, 1, k1);
            PG8_WAIT_V(8); PG8_WAIT_L(0); PG8_BAR; PG8_MMA(0, 0, At, B0); PG8_MMA(0, 1, At, B1); PG8_BAR; PG8_SCHED;
            PG8_LDA(At, 0, 1); PG8_STAGEB(PG8_SB(0, 0), b2); PG8_STAGEB(PG8_SB(0, 1), b2 + hstep); PG8_STAGEA(PG8_SA(0, 0), cAr, cv, 0, k2);
            PG8_WAIT_V(8); PG8_WAIT_L(0); PG8_BAR; PG8_MMA(1, 0, At, B0); PG8_MMA(1, 1, At, B1); PG8_BAR; PG8_SCHED;
            PG8_LDB(B0, 1, 0); PG8_LDB(B1, 1, 1); PG8_SCHED; PG8_LDA(At, 1, 0); PG8_STAGEA(PG8_SA(0, 1), cAr, cv, 1, k2);
            PG8_WAIT_V(8); PG8_WAIT_L(0); PG8_BAR; PG8_MMA(0, 0, At, B0); PG8_MMA(0, 1, At, B1); PG8_BAR; PG8_SCHED;
            PG8_LDA(At, 1, 1); PG8_STAGEB(PG8_SB(1, 0), b3); PG8_STAGEB(PG8_SB(1, 1), b3 + hstep); PG8_STAGEA(PG8_SA(1, 0), cAr, cv, 0, k3);
            PG8_WAIT_V(8); PG8_WAIT_L(0); PG8_BAR; PG8_MMA(1, 0, At, B0); PG8_MMA(1, 1, At, B1); PG8_BAR; PG8_SCHED;
        }
        {
            const size_t k1 = (size_t)(nt - 1) * kstep;
            PG8_LDB(B0, 0, 0); PG8_LDB(B1, 0, 1); PG8_SCHED; PG8_LDA(At, 0, 0); PG8_STAGEA(PG8_SA(1, 1), cAr, cv, 1, k1);
            PG8_WAIT_V(8); PG8_WAIT_L(0); PG8_BAR; PG8_MMA(0, 0, At, B0); PG8_MMA(0, 1, At, B1); PG8_BAR; PG8_SCHED;
            PG8_LDA(At, 0, 1); PG8_STAGEB(PG8_SB(0, 0), nB); PG8_STAGEB(PG8_SB(0, 1), nB + hstep); PG8_STAGEA(PG8_SA(0, 0), nAr, nv, 0, 0);
            PG8_WAIT_V(8); PG8_WAIT_L(0); PG8_BAR; PG8_MMA(1, 0, At, B0); PG8_MMA(1, 1, At, B1); PG8_BAR; PG8_SCHED;
            PG8_LDB(B0, 1, 0); PG8_LDB(B1, 1, 1); PG8_SCHED; PG8_LDA(At, 1, 0); PG8_STAGEA(PG8_SA(0, 1), nAr, nv, 1, 0);
            PG8_WAIT_V(8); PG8_WAIT_L(0); PG8_BAR; PG8_MMA(0, 0, At, B0); PG8_MMA(0, 1, At, B1); PG8_BAR; PG8_SCHED;
            PG8_LDA(At, 1, 1); PG8_STAGEB(PG8_SB(1, 0), nB + kstep); PG8_STAGEB(PG8_SB(1, 1), nB + hstep + kstep); PG8_STAGEA(PG8_SA(1, 0), nAr, nv, 0, kstep);
            PG8_WAIT_V(8); PG8_WAIT_L(0); PG8_BAR; PG8_MMA(1, 0, At, B0); PG8_MMA(1, 1, At, B1); PG8_BAR; PG8_SCHED;
        }
        if (wr == 0) PG8_BAR;
        if constexpr (MODE != 0) asm volatile("s_nop 15\n\ts_nop 15" ::: "memory");
        if constexpr (MODE == 2) {
#pragma unroll
            for (int a = 0; a < 2; ++a)
#pragma unroll
                for (int m = 0; m < 4; ++m) { const float rs = __builtin_bit_cast(float, __builtin_amdgcn_ds_bpermute((m * 16 + fr) * 4, __builtin_bit_cast(int, rs2[a])));
#pragma unroll
                    for (int b = 0; b < 2; ++b)
#pragma unroll
                        for (int n = 0; n < 2; ++n) { const v4i_t iv = __builtin_bit_cast(v4i_t, acc[a][b][m][n]); acc[a][b][m][n] = (f32x4){(float)iv[0], (float)iv[1], (float)iv[2], (float)iv[3]} * rs; } }
        }
        E(acc, cur, wr, wc, fr, fq);
        if (!has_next) break;
#pragma unroll
        for (int a = 0; a < 2; ++a)
#pragma unroll
            for (int b = 0; b < 2; ++b)
#pragma unroll
                for (int m = 0; m < 4; ++m)
#pragma unroll
                    for (int n = 0; n < 2; ++n) acc[a][b][m][n] = (f32x4){0.f, 0.f, 0.f, 0.f};
        cur = nxt; cB = nB; cAr = nAr; ++ui;
#pragma unroll
        for (int h = 0; h < 2; ++h)
#pragma unroll
            for (int i = 0; i < 2; ++i) cv[h][i] = nv[h][i];
        if (wr == 1) PG8_BAR;
    }
    PG8_WAIT_V(0);
    PG8_BAR;
#undef PG8_SA
#undef PG8_SB
#undef PG8_STAGEA
#undef PG8_STAGEB
#undef PG8_LDA
#undef PG8_LDB
#undef PG8_MMA
#undef PG8_WAIT_V
#undef PG8_WAIT_L
#undef PG8_BAR
#undef PG8_SCHED
#undef PG8_VOFF
}
}

#ifndef WGM_IN
#define WGM_IN 8
#endif
#ifndef WGM_OUT
#define WGM_OUT 4
#endif
#ifndef WGM_GU
#define WGM_GU 4
#endif
#ifndef WGM_DN
#define WGM_DN 4
#endif
constexpr int NWAVES = 8;
constexpr int N_LAUNCHES = MK_N_LAUNCHES;
constexpr int PER_PHASE = 11;

constexpr size_t MiB = 1u << 20;
constexpr size_t WS_CTL = 0, CTL_ZERO_BYTES = 32768;
constexpr size_t WS_MOD = 1 * MiB;
constexpr size_t WS_ROPE = 2 * MiB;
constexpr size_t WS_TOPI = 10 * MiB;
constexpr size_t WS_GATE = WS_TOPI + 256 * 1024;
constexpr size_t WS_RANK = WS_GATE + 256 * 1024;
constexpr size_t WS_TSLOT = WS_RANK + 256 * 1024;
constexpr size_t WS_SLOTTOK = 11 * MiB;
constexpr size_t WS_WSP = 13 * MiB;
constexpr size_t WS_TILEE = 12 * MiB;
constexpr size_t WS_WIN = 16 * MiB;
constexpr size_t WS_WOUT = 38 * MiB;
constexpr size_t WS_H = 48 * MiB;
constexpr size_t WS_Q = 112 * MiB, WS_K = 160 * MiB, WS_V = 208 * MiB;
constexpr size_t WS_U = 256 * MiB, WS_VG = 272 * MiB;
constexpr size_t WS_CAT = 288 * MiB;
constexpr size_t WS_OPART = 352 * MiB;
constexpr size_t WS_LSE = 496 * MiB;
constexpr size_t WS_Y1 = 512 * MiB;
constexpr size_t WS_X1 = 576 * MiB;
constexpr size_t WS_WGU = 640 * MiB;
constexpr size_t WS_WD = 896 * MiB;
constexpr size_t WS_ACT = 1024 * MiB;
constexpr size_t WS_YS = 1168 * MiB;
constexpr size_t WS_H8 = 1456 * MiB;
constexpr size_t WS_RSH = 14 * MiB, WS_RSCAT = WS_RSH + 65536, WS_RSH2 = WS_RSCAT + 65536, WS_RSRATIO = WS_RSH2 + 65536, WS_RSSLOT = 15 * MiB;
constexpr size_t WS_GMO = 1488 * MiB;
constexpr size_t WS_HB = 1488 * MiB;
#ifndef BF_LO
#define BF_LO 22
#endif
#ifndef BF_HI
#define BF_HI 22
#endif
constexpr size_t WS_WINU = 1552 * MiB;
constexpr size_t WS_X8 = 1488 * MiB;
constexpr size_t WS_END = 1632 * MiB;
static_assert(WS_WINU + (size_t)(BF_HI - BF_LO) * 256 * D * 2 <= WS_END, "bf16 in-projection tiles");
constexpr float SC_H = 8.0f, SC_WGU = 127.0f / (4.5f * 0.022097087f), SC_ACT = 4.0f, SC_WD = 1024.0f, SC_WIN = 127.0f / (4.5f * 0.022097087f), SC_YS = 64.0f, SC_WOUT = 127.0f / (4.5f * 0.013148672f);
constexpr int CW_CNT = 1024, CW_CNT_STRIDE = 32;
constexpr int CW_BAR = 4096;
static_assert((CW_BAR + 3456) * 4 <= (int)CTL_ZERO_BYTES, "control words inside the per-call memset");

constexpr int RING_OFF = 0, RING_BYTES = 131072;
constexpr int LDSCTL_OFF = 143360, MISC_OFF = LDSCTL_OFF + 320;
constexpr int LDS_BYTES = 147456;

#define GAS __attribute__((address_space(1)))
#define LAS __attribute__((address_space(3)))
typedef unsigned short bf16;
typedef unsigned v4u __attribute__((ext_vector_type(4)));
typedef unsigned v2u __attribute__((ext_vector_type(2)));
typedef float f32x4 __attribute__((ext_vector_type(4)));
typedef GAS unsigned gu32;
#define RLX_AGENT __ATOMIC_RELAXED, __HIP_MEMORY_SCOPE_AGENT
#define LDS_WAIT() asm volatile("s_waitcnt lgkmcnt(0)" ::: "memory")
#define VM_WAIT() asm volatile("s_waitcnt vmcnt(0)" ::: "memory")
__device__ __forceinline__ unsigned f2bf(float f) { unsigned u = __builtin_bit_cast(unsigned, f); return (u + 0x7fffu + ((u >> 16) & 1u)) >> 16; }
__device__ __forceinline__ unsigned pk2(float lo, float hi) { return f2bf(lo) | (f2bf(hi) << 16); }
__device__ __forceinline__ float bf2f(unsigned short b) { return __builtin_bit_cast(float, ((unsigned)b) << 16); }
__device__ __forceinline__ float bflo(unsigned w) { return __builtin_bit_cast(float, w << 16); }
__device__ __forceinline__ float bfhi(unsigned w) { return __builtin_bit_cast(float, w & 0xffff0000u); }

#define XB_TMO      128
#define XB_XCNT(j)  (256  + 64 * (j))
#define XB_XSUB(j)  (1280 + 64 * (j))
#define XB_XGEN(j)  (2304 + 64 * (j))
#define XB_TOP      3328
#define XB_TOPGEN   3392
#define XCD_BAR_WORDS 3456
#define XB_SPIN_CAP (1u << 18)
__device__ __forceinline__ unsigned xb_ld(unsigned* p)              { return __hip_atomic_load(p, __ATOMIC_RELAXED, __HIP_MEMORY_SCOPE_AGENT); }
__device__ __forceinline__ unsigned xb_add(unsigned* p, unsigned v) { return __hip_atomic_fetch_add(p, v, __ATOMIC_RELAXED, __HIP_MEMORY_SCOPE_AGENT); }
__device__ __forceinline__ unsigned xb_xcc_id() { return (unsigned)__builtin_amdgcn_s_getreg((3 << 11) | 20) & 0xFu; }
#define XB_SPIN(cond, bar) do { unsigned _sp = 0; while (cond) { __builtin_amdgcn_s_sleep(1); \
    if ((++_sp & 255u) == 0u) { if (xb_ld(&(bar)[XB_TMO])) break; if (_sp > XB_SPIN_CAP) { atomicAdd(&(bar)[XB_TMO], 1u); break; } } } } while (0)
struct XcdBarrier { unsigned* bar; unsigned x; volatile LAS unsigned* st; };
__device__ __forceinline__ XcdBarrier xcd_barrier_post(unsigned* bar, volatile LAS unsigned* st) {
    XcdBarrier b; b.bar = bar; b.x = xb_xcc_id(); b.st = st;
    if (threadIdx.x == 0) (void)xb_add(&bar[XB_XCNT(b.x)], 1u);
    return b;
}
__device__ __forceinline__ void xcd_barrier_complete(unsigned* bar, unsigned x, unsigned& nloc, unsigned& nx) {
    const unsigned G = gridDim.x * gridDim.y * gridDim.z;
    unsigned sum, cnt, mine, sp = 0u;
    for (;;) {
        sum = 0u; cnt = 0u; mine = 0u;
#pragma unroll
        for (unsigned j = 0; j < 16; ++j) { const unsigned c = xb_ld(&bar[XB_XCNT(j)]); sum += c; cnt += (c > 0u) ? 1u : 0u; mine = (j == x) ? c : mine; }
        if (sum == G) break;
        __builtin_amdgcn_s_sleep(1);
        if ((++sp & 255u) == 0u) { if (xb_ld(&bar[XB_TMO])) break; if (sp > XB_SPIN_CAP) { atomicAdd(&bar[XB_TMO], 1u); break; } }
    }
    nloc = mine > 0u ? mine : 1u; nx = cnt > 0u ? cnt : 1u;
}
__device__ __forceinline__ void xcd_barrier(const XcdBarrier& b) {
    asm volatile("s_waitcnt vmcnt(0)" ::: "memory");
    __syncthreads();
    if (threadIdx.x == 0) {
        unsigned* bar = b.bar;
        __builtin_amdgcn_s_waitcnt(0);
        unsigned nloc = b.st[0], nx = b.st[1];
        if (nloc == 0u) { xcd_barrier_complete(bar, b.x, nloc, nx); b.st[0] = nloc; b.st[1] = nx; }
        const unsigned old = xb_add(&bar[XB_XSUB(b.x)], 1u);
        const unsigned gen = old / nloc;
        if (old + 1u == (gen + 1u) * nloc) {
            __builtin_amdgcn_fence(__ATOMIC_RELEASE, "agent");
            asm volatile("s_waitcnt vmcnt(0)" ::: "memory");
            const unsigned og = xb_add(&bar[XB_TOP], 1u);
            const unsigned tg = og / nx;
            if (og + 1u == (tg + 1u) * nx) xb_add(&bar[XB_TOPGEN], 1u);
            else XB_SPIN(xb_ld(&bar[XB_TOPGEN]) == tg, bar);
            __builtin_amdgcn_fence(__ATOMIC_ACQUIRE, "agent");
            xb_add(&bar[XB_XGEN(b.x)], 1u);
            asm volatile("s_waitcnt vmcnt(0)" ::: "memory");
        } else {
            XB_SPIN(xb_ld(&bar[XB_XGEN(b.x)]) == gen, bar);
            __builtin_amdgcn_fence(__ATOMIC_ACQUIRE, "agent");
            asm volatile("s_waitcnt vmcnt(0)" ::: "memory");
        }
    }
    __syncthreads();
}

struct Args {
    const float *x, *c; const int* pos; const float *ada_w, *ada_b, *w_in, *w_sp, *b_sp, *gln_g, *gln_b, *w_out, *ln1_g, *ln1_b, *rw, *rb, *wgu, *bgu, *wd, *bd, *ln2_g, *ln2_b;
    float* out; unsigned char* ws; int ph_lo, ph_hi;
};

struct Frame {
    LAS unsigned char* lds;
    volatile LAS unsigned* MISC;
    unsigned* ctl;
    int tid, lane, wave, vcu, G;
};

#define PHASE_IDS(F) do { int t_ = threadIdx.x; asm volatile("" : "+v"(t_)); (F).tid = t_; (F).lane = t_ & 63; } while (0)
__device__ __forceinline__ float wave_sum(float v) {
#pragma unroll
    for (int o = 1; o < 64; o <<= 1) v += __shfl_xor(v, o);
    return v;
}
__device__ __forceinline__ int f8x4(float a, float b, float c, float d, float sc) {
    a = fminf(fmaxf(a * sc, -448.0f), 448.0f); b = fminf(fmaxf(b * sc, -448.0f), 448.0f); c = fminf(fmaxf(c * sc, -448.0f), 448.0f); d = fminf(fmaxf(d * sc, -448.0f), 448.0f);
    int w = __builtin_amdgcn_cvt_pk_fp8_f32(a, b, 0, false); return __builtin_amdgcn_cvt_pk_fp8_f32(c, d, w, true);
}
__device__ __forceinline__ unsigned f8x4u(float a, float b, float c, float d, float sc) {
    int w = __builtin_amdgcn_cvt_pk_fp8_f32(a * sc, b * sc, 0, false); return (unsigned)__builtin_amdgcn_cvt_pk_fp8_f32(c * sc, d * sc, w, true);
}
__device__ __forceinline__ unsigned q8x4(float a, float b, float c, float d, float sc) {
    const float M = 12582912.0f;
    const unsigned ua = __builtin_bit_cast(unsigned, __builtin_amdgcn_fmed3f(__builtin_fmaf(a, sc, M), M - 127.0f, M + 127.0f)), ub = __builtin_bit_cast(unsigned, __builtin_amdgcn_fmed3f(__builtin_fmaf(b, sc, M), M - 127.0f, M + 127.0f));
    const unsigned uc = __builtin_bit_cast(unsigned, __builtin_amdgcn_fmed3f(__builtin_fmaf(c, sc, M), M - 127.0f, M + 127.0f)), ud = __builtin_bit_cast(unsigned, __builtin_amdgcn_fmed3f(__builtin_fmaf(d, sc, M), M - 127.0f, M + 127.0f));
    return __builtin_amdgcn_perm(ub, ua, 0x0c0c0400u) | __builtin_amdgcn_perm(ud, uc, 0x04000c0cu);
}
__device__ __forceinline__ float wave_max(float v) {
#pragma unroll
    for (int o = 1; o < 64; o <<= 1) v = fmaxf(v, __shfl_xor(v, o));
    return v;
}

__device__ __forceinline__ void p0_transpose_item(const float* W, int K, int N, bf16* WT, int k0, int n0, int drow0, LAS float* scr, int lane) {
#pragma unroll 8
    for (int i = 0; i < 32; ++i) { const int kk = 2 * i + (lane >> 5); scr[kk * 33 + (lane & 31)] = W[(size_t)(k0 + kk) * N + n0 + (lane & 31)]; }
    LDS_WAIT(); asm volatile("" ::: "memory");
    const int c = lane & 7;
#pragma unroll
    for (int j = 0; j < 4; ++j) { const int n = (lane >> 3) + 8 * j; const LAS float* s = scr + (8 * c) * 33 + n;
        v4u o; o.x = pk2(s[0 * 33], s[1 * 33]); o.y = pk2(s[2 * 33], s[3 * 33]); o.z = pk2(s[4 * 33], s[5 * 33]); o.w = pk2(s[6 * 33], s[7 * 33]);
        *(GAS v4u*)(WT + (size_t)(drow0 + n) * K + k0 + 8 * c) = o; }
    LDS_WAIT(); asm volatile("" ::: "memory");
}
#define FP8_ITEM_LOAD(rv, W, N, k0, n0) do { const float* wsrc_ = (W) + (size_t)((k0) + (lane >> 5)) * (N) + (n0) + (lane & 31); \
        _Pragma("unroll") for (int i_ = 0; i_ < 64; ++i_) rv[i_] = __builtin_nontemporal_load(wsrc_ + (size_t)(2 * i_) * (N)); } while (0)
#define W8_ITEM_STORE(PK, rv, K, WT, k0, drow0, scale) do { \
        _Pragma("unroll") for (int i_ = 0; i_ < 64; ++i_) scr[(2 * i_ + (lane >> 5)) * 33 + (lane & 31)] = rv[i_]; \
        LDS_WAIT(); asm volatile("" ::: "memory"); \
        const int c_ = lane & 7; \
        _Pragma("unroll") for (int j_ = 0; j_ < 4; ++j_) { const int n_ = (lane >> 3) + 8 * j_; const LAS float* s_ = scr + (16 * c_) * 33 + n_; v4u o_; \
            o_.x = PK(s_[0 * 33], s_[1 * 33], s_[2 * 33], s_[3 * 33], (scale)); o_.y = PK(s_[4 * 33], s_[5 * 33], s_[6 * 33], s_[7 * 33], (scale)); \
            o_.z = PK(s_[8 * 33], s_[9 * 33], s_[10 * 33], s_[11 * 33], (scale)); o_.w = PK(s_[12 * 33], s_[13 * 33], s_[14 * 33], s_[15 * 33], (scale)); \
            __builtin_nontemporal_store(o_, (GAS v4u*)((WT) + (size_t)((drow0) + n_) * (K) + (k0) + 16 * c_)); } \
        LDS_WAIT(); asm volatile("" ::: "memory"); } while (0)
#define FP8_ITEM_STORE(rv, K, WT, k0, drow0, scale) W8_ITEM_STORE(f8x4u, rv, K, WT, k0, drow0, scale)

#define I8_ITEM_STORE(rv, K, WT, k0, drow0, scale) W8_ITEM_STORE(q8x4, rv, K, WT, k0, drow0, scale)
__device__ __forceinline__ int map_win(int ca) {
    if (ca >= 2 * AW) return ca;
    const int pn = ca >> 8, w = ca & 255, hh = w >> 7, i = w & 127;
    return (pn << 8) + ((i >> 6) << 7) + (hh << 6) + (i & 63);
}
__device__ __forceinline__ int map_wgu(int ca) {
    return ca < DFF ? ((ca >> 7) << 8) + (ca & 127) : (((ca - DFF) >> 7) << 8) + 128 + (ca & 127);
}

__device__ __forceinline__ void phase0(Frame& F, const Args& a) {
    PHASE_IDS(F);
    unsigned char* ws = a.ws;
    if (blockIdx.x < (6 * D) / 64) {
        LAS float* sl = (LAS float*)(F.lds);
        LAS float* red = (LAS float*)(F.lds + 32768);
        for (int i = F.tid; i < BATCH * D; i += NWAVES * 64) { const float v = a.c[i]; sl[i] = v / (1.0f + __expf(-v)); }
        __syncthreads();
        const int j = blockIdx.x * 64 + F.lane, k0 = F.wave * 256;
        float s0 = 0.f, s1 = 0.f, s2 = 0.f, s3 = 0.f;
        for (int kb = 0; kb < 256; kb += 64) {
            float wv[64];
#pragma unroll
            for (int k = 0; k < 64; ++k) wv[k] = __builtin_nontemporal_load(a.ada_w + (size_t)(k0 + kb + k) * (6 * D) + j);
#pragma unroll
            for (int k = 0; k < 64; ++k) { const float w = wv[k]; const int kk = k0 + kb + k;
                s0 += sl[kk] * w; s1 += sl[D + kk] * w; s2 += sl[2 * D + kk] * w; s3 += sl[3 * D + kk] * w; } }
        red[(F.wave * 4 + 0) * 64 + F.lane] = s0; red[(F.wave * 4 + 1) * 64 + F.lane] = s1; red[(F.wave * 4 + 2) * 64 + F.lane] = s2; red[(F.wave * 4 + 3) * 64 + F.lane] = s3;
        __syncthreads();
        if (F.tid < 256) { const int b = F.tid >> 6, l = F.tid & 63; float s = a.ada_b[blockIdx.x * 64 + l];
#pragma unroll
            for (int w = 0; w < 8; ++w) s += red[(w * 4 + b) * 64 + l];
            ((float*)(ws + WS_MOD))[(size_t)b * (6 * D) + blockIdx.x * 64 + l] = s; }
        __syncthreads();
    }
    if (blockIdx.x == F.G - 1) {
        for (int i = F.tid; i < 4 * 128 * 128 / 2; i += NWAVES * 64) { const int e0 = 2 * i, t = (e0 >> 7) & 127, s0 = e0 & 127; const float2 w = *(const float2*)(a.w_sp + e0);
            ((unsigned*)(ws + WS_WSP))[i] = pk2(s0 <= t ? w.x : 0.f, s0 + 1 <= t ? w.y : 0.f); }
    }
    const int gw = F.vcu * NWAVES + F.wave, NGW = F.G * NWAVES;
    for (int m = gw; m < T; m += NGW) {
        const float p = (float)a.pos[m];
        const float inv = exp2f(-(float)F.lane * (13.287712379549449f / 64.0f));
        float sn, cs; sincosf(p * inv, &sn, &cs);
        typedef _Float16 h16x2 __attribute__((ext_vector_type(2)));
        ((h16x2*)(ws + WS_ROPE))[(size_t)m * 64 + F.lane] = (h16x2){(_Float16)cs, (_Float16)sn};
    }
    LAS float* scr = (LAS float*)(F.lds + RING_OFF + F.wave * 16896);
    constexpr int I_IN = (D / 128) * (NPROJ / 32), I_OUT = (D / 128) * (D / 32), I_GU = (D / 128) * (2 * DFF / 32), I_D = (DFF / 128) * (D / 32);
    constexpr int I_U = (D / 64) * ((BF_HI - BF_LO) * 256 / 32);
    constexpr int NITEMS = I_IN + I_OUT + I_U;
    for (int it = gw; it < NITEMS; it += NGW) {
        int r = it;
        if (r < I_IN) { const int nb = NPROJ / 32, k0 = 128 * (r / nb), n0 = 32 * (r % nb), lane = F.lane; float rv[64]; LAS float* scr8 = (LAS float*)(F.lds + RING_OFF + F.wave * 16896);
            FP8_ITEM_LOAD(rv, a.w_in, NPROJ, k0, n0); { LAS float* scr = scr8; I8_ITEM_STORE(rv, D, ws + WS_WIN, k0, map_win(n0), SC_WIN); } continue; } r -= I_IN;
        if (r < I_OUT) { const int nb = D / 32, k0 = 128 * (r / nb), n0 = 32 * (r % nb), lane = F.lane; float rv[64]; LAS float* scr8 = (LAS float*)(F.lds + RING_OFF + F.wave * 16896);
            FP8_ITEM_LOAD(rv, a.w_out, D, k0, n0); { LAS float* scr = scr8; I8_ITEM_STORE(rv, D, ws + WS_WOUT, k0, n0, SC_WOUT); } continue; } r -= I_OUT;
        { const int nb = (BF_HI - BF_LO) * 256 / 32, k0 = 64 * (r / nb), n0 = BF_LO * 256 + 32 * (r % nb); p0_transpose_item(a.w_in, D, NPROJ, (bf16*)(ws + WS_WINU), k0, n0, map_win(n0) - BF_LO * 256, scr, F.lane); }
        (void)I_GU; (void)I_D;
    }
}
constexpr int CONV_I_GU = NE * (D / 128) * (2 * DFF / 32), CONV_I_D = NE * (DFF / 128) * (D / 32), CONV_ITEMS = CONV_I_GU + CONV_I_D;
constexpr int CONV_PER_WAVE = 2, CONV_CHUNK = 8 * CONV_PER_WAVE, CONV_NCHUNK = CONV_ITEMS / CONV_CHUNK;
constexpr int CW_CONV = 128;
struct ConvItem { const float* W; unsigned char* WT; int KK, NN, k0, n0, d0; float scale; bool i8; };
__device__ __forceinline__ ConvItem conv_decode(const Args& a, int r) {
    ConvItem c;
    if (r < CONV_I_GU) { constexpr int PER = (D / 128) * (2 * DFF / 32), NB = 2 * DFF / 32; const int e = r / PER, q = r % PER; c.KK = D; c.NN = 2 * DFF; c.k0 = 128 * (q / NB); c.n0 = 32 * (q % NB); c.d0 = map_wgu(c.n0);
        c.W = a.wgu + (size_t)e * D * 2 * DFF; c.WT = a.ws + WS_WGU + (size_t)e * 2 * DFF * D; c.scale = SC_WGU; c.i8 = true; }
    else { r -= CONV_I_GU; constexpr int PER = (DFF / 128) * (D / 32), NB = D / 32; const int e = r / PER, q = r % PER; c.KK = DFF; c.NN = D; c.k0 = 128 * (q / NB); c.n0 = 32 * (q % NB); c.d0 = c.n0;
        c.W = a.wd + (size_t)e * DFF * D; c.WT = a.ws + WS_WD + (size_t)e * D * DFF; c.scale = SC_WD; c.i8 = false; }
    return c;
}
__device__ __forceinline__ void conv_dyn(Frame& F, const Args& a, int limit) {
    PHASE_IDS(F);
    const int lane = F.lane;
    LAS float* scr = (LAS float*)(F.lds + RING_OFF + F.wave * 16896);
    volatile LAS int* slot = (volatile LAS int*)(F.lds + 8 * 16896);
    __syncthreads();
    if (F.tid == 0) { const int c0 = (int)__hip_atomic_fetch_add(F.ctl + CW_CONV, 1u, RLX_AGENT); slot[0] = c0;
        slot[1] = (c0 < limit) ? (int)__hip_atomic_fetch_add(F.ctl + CW_CONV, 1u, RLX_AGENT) : CONV_NCHUNK; }
    __syncthreads();
    int id = slot[0], nid = slot[1], par = 0;
    float ra[64], rb[64];
    if (id < CONV_NCHUNK) {
        const int r0 = id * CONV_CHUNK + F.wave * 2;
        { const ConvItem c = conv_decode(a, r0); FP8_ITEM_LOAD(ra, c.W, c.NN, c.k0, c.n0); }
        { const ConvItem c = conv_decode(a, r0 + 1); FP8_ITEM_LOAD(rb, c.W, c.NN, c.k0, c.n0); }
    }
    while (id < CONV_NCHUNK) {
        if (F.tid == 0) slot[2 + par] = (nid < limit) ? (int)__hip_atomic_fetch_add(F.ctl + CW_CONV, 1u, RLX_AGENT) : CONV_NCHUNK;
        const int r0 = id * CONV_CHUNK + F.wave * 2, n0 = nid * CONV_CHUNK + F.wave * 2;
        { const ConvItem c = conv_decode(a, r0); if (c.i8) I8_ITEM_STORE(ra, c.KK, c.WT, c.k0, c.d0, c.scale); else FP8_ITEM_STORE(ra, c.KK, c.WT, c.k0, c.d0, c.scale); }
        if (nid < CONV_NCHUNK) { const ConvItem c = conv_decode(a, n0); FP8_ITEM_LOAD(ra, c.W, c.NN, c.k0, c.n0); }
        { const ConvItem c = conv_decode(a, r0 + 1); if (c.i8) I8_ITEM_STORE(rb, c.KK, c.WT, c.k0, c.d0, c.scale); else FP8_ITEM_STORE(rb, c.KK, c.WT, c.k0, c.d0, c.scale); }
        if (nid < CONV_NCHUNK) { const ConvItem c = conv_decode(a, n0 + 1); FP8_ITEM_LOAD(rb, c.W, c.NN, c.k0, c.n0); }
        __syncthreads();
        id = nid; nid = slot[2 + par]; par ^= 1;
    }
    __syncthreads();
}

__device__ __forceinline__ void phase1(Frame& F, const Args& a) {
    PHASE_IDS(F);
    const int gw = F.vcu * NWAVES + F.wave, NGW = F.G * NWAVES;
    const float* mod = (const float*)(a.ws + WS_MOD);
    bf16* H = (bf16*)(a.ws + WS_H);
    f32x4 vn[8];
    if (gw < T) {
#pragma unroll
        for (int j = 0; j < 8; ++j) vn[j] = __builtin_nontemporal_load((const f32x4*)(a.x + (size_t)gw * D) + F.lane + 64 * j);
    }
    for (int m = gw; m < T; m += NGW) {
        f32x4 v[8]; float s = 0.f;
#pragma unroll
        for (int j = 0; j < 8; ++j) { v[j] = vn[j]; s += (v[j].x + v[j].y) + (v[j].z + v[j].w); }
        if (m + NGW < T) {
#pragma unroll
            for (int j = 0; j < 8; ++j) vn[j] = __builtin_nontemporal_load((const f32x4*)(a.x + (size_t)(m + NGW) * D) + F.lane + 64 * j);
        }
        const float mean = wave_sum(s) * (1.f / D); float s2 = 0.f;
#pragma unroll
        for (int j = 0; j < 8; ++j) { v[j] = v[j] - mean; s2 += (v[j].x * v[j].x + v[j].y * v[j].y) + (v[j].z * v[j].z + v[j].w * v[j].w); }
        const float rstd = 1.f / sqrtf(wave_sum(s2) * (1.f / D) + LN_EPS);
        const float* mb = mod + (size_t)(m / SEQ) * (6 * D);
        unsigned* o4 = (unsigned*)((unsigned char*)H + (size_t)m * D) + F.lane; float am = 0.f;
#pragma unroll
        for (int j = 0; j < 8; ++j) { const f32x4 sh = *((const f32x4*)mb + F.lane + 64 * j), sc = *((const f32x4*)(mb + D) + F.lane + 64 * j);
            v[j] = v[j] * rstd * (sc + 1.0f) + sh; am = fmaxf(fmaxf(am, fmaxf(fabsf(v[j].x), fabsf(v[j].y))), fmaxf(fabsf(v[j].z), fabsf(v[j].w))); }
        am = fmaxf(wave_max(am), 1e-20f);
        const float qs = 127.0f / am;
#pragma unroll
        for (int j = 0; j < 8; ++j) o4[64 * j] = q8x4(v[j].x, v[j].y, v[j].z, v[j].w, qs);
        if (F.lane == 0) ((float*)(a.ws + WS_RSH))[m] = am * (1.0f / 127.0f);
    }
}

__device__ __forceinline__ void phase3_attn_naive(Frame& F, const Args& a) {
    const int gw = F.vcu * NWAVES + F.wave, NGW = F.G * NWAVES;
    const bf16* Q = (const bf16*)(a.ws + WS_Q); const bf16* Kb = (const bf16*)(a.ws + WS_K); const bf16* Vb = (const bf16*)(a.ws + WS_V);
    bf16* CAT = (bf16*)(a.ws + WS_CAT);
    for (int it = gw; it < T * NH; it += NGW) {
        const int m = it / NH, h = it % NH, b = m / SEQ, t = m % SEQ;
        const unsigned qw = *((const unsigned*)(Q + (size_t)m * AW + h * HD) + F.lane);
        const float q0 = bflo(qw), q1 = bfhi(qw);
        float mx = -1e30f, l = 0.f, o0 = 0.f, o1 = 0.f;
        for (int c0 = 0; c0 < 3 * 129; c0 += 4) {
            float sc[4]; unsigned vw[4];
#pragma unroll
            for (int u = 0; u < 4; ++u) {
                const int c = c0 + u, br = c / 129, j = c - br * 129, dil = 1 << (2 * br), p = t - dil * j;
                const bool ok = (c < 3 * 129) && (p >= 0);
                const size_t row = (size_t)(b * SEQ + (ok ? p : t));
                const unsigned kw = *((const unsigned*)(Kb + row * AW + h * HD) + F.lane);
                vw[u] = *((const unsigned*)(Vb + row * AW + h * HD) + F.lane);
                const float d = wave_sum(q0 * bflo(kw) + q1 * bfhi(kw));
                sc[u] = ok ? d : -1e30f;
            }
            const float cm = fmaxf(fmaxf(sc[0], sc[1]), fmaxf(sc[2], sc[3])), nm = fmaxf(mx, cm), r = __expf(mx - nm);
            l *= r; o0 *= r; o1 *= r; mx = nm;
#pragma unroll
            for (int u = 0; u < 4; ++u) { const float pp = sc[u] > -1e29f ? __expf(sc[u] - nm) : 0.f; l += pp; o0 += pp * bflo(vw[u]); o1 += pp * bfhi(vw[u]); }
        }
        const float il = 1.0f / l;
        *((unsigned*)(CAT + (size_t)m * D + h * HD) + F.lane) = pk2(o0 * il, o1 * il);
    }
}
__device__ __forceinline__ int pi16(int k) { return (k & ~12) | ((k & 4) << 1) | ((k & 8) >> 1); }
__device__ __forceinline__ int fswz(int R) { return ((R & 3) << 2) | ((R >> 2) & 3); }
__device__ __forceinline__ void phase3_gmlp(Frame& F, const Args& a) {
    PHASE_IDS(F);
    typedef short s16x4 __attribute__((ext_vector_type(4)));
    typedef short bf16x8_t __attribute__((ext_vector_type(8)));
    typedef __attribute__((__vector_size__(4 * sizeof(short)))) short v4i16_t;
    const bf16* U = (const bf16*)(a.ws + WS_U); const bf16* VG = (const bf16*)(a.ws + WS_VG); bf16* GMO = (bf16*)(a.ws + WS_GMO); const bf16* WSP = (const bf16*)(a.ws + WS_WSP);
    constexpr int NUNITS = BATCH * (SEQ / 128) * 2;
    const int lane = F.lane, wid = F.wave, fr = lane & 15, fq = lane >> 4;
    for (int un = F.vcu; un < NUNITS; un += F.G) {
        const int gp = un & 1, ch = un >> 1;
        __syncthreads();
        v4u wrow[16];
#pragma unroll
        for (int rr = 0; rr < 16; ++rr) wrow[rr] = *((const v4u*)(VG + ((size_t)ch * 128 + wid * 16 + rr) * GW) + lane);
        const f32x4 lg0 = *((const f32x4*)a.gln_g + 2 * lane), lg1 = *((const f32x4*)a.gln_g + 2 * lane + 1), lb0 = *((const f32x4*)a.gln_b + 2 * lane), lb1 = *((const f32x4*)a.gln_b + 2 * lane + 1);
        const int nks = (16 * wid + 15) / 32 + 1;
        bf16x8_t wf[2][4];
#pragma unroll
        for (int g2 = 0; g2 < 2; ++g2)
#pragma unroll
            for (int ks = 0; ks < 4; ++ks) wf[g2][ks] = (ks < nks) ? *(const bf16x8_t*)(WSP + ((size_t)(2 * gp + g2) * 128 + 16 * wid + fr) * 128 + 32 * ks + 8 * fq) : (bf16x8_t){0, 0, 0, 0, 0, 0, 0, 0};
#pragma unroll
        for (int rr = 0; rr < 16; ++rr) {
            const int s_ = wid * 16 + rr;
            const v4u w = wrow[rr];
            float v[8] = {bflo(w.x), bfhi(w.x), bflo(w.y), bfhi(w.y), bflo(w.z), bfhi(w.z), bflo(w.w), bfhi(w.w)};
            float sm = 0.f;
#pragma unroll
            for (int i = 0; i < 8; ++i) sm += v[i];
            const float mean = wave_sum(sm) * (1.f / GW); float s2 = 0.f;
#pragma unroll
            for (int i = 0; i < 8; ++i) { v[i] -= mean; s2 += v[i] * v[i]; }
            const float rstd = 1.f / sqrtf(wave_sum(s2) * (1.f / GW) + LN_EPS);
            if ((lane >> 5) == gp) {
                v4u o; o.x = pk2(v[0] * rstd * lg0.x + lb0.x, v[1] * rstd * lg0.y + lb0.y); o.y = pk2(v[2] * rstd * lg0.z + lb0.z, v[3] * rstd * lg0.w + lb0.w);
                o.z = pk2(v[4] * rstd * lg1.x + lb1.x, v[5] * rstd * lg1.y + lb1.y); o.w = pk2(v[6] * rstd * lg1.z + lb1.z, v[7] * rstd * lg1.w + lb1.w);
                *(LAS v4u*)(F.lds + ((lane >> 4) & 1) * 32768 + s_ * 256 + (((lane & 15) ^ fswz(s_)) << 4)) = o;
            }
        }
        LDS_WAIT();
        __syncthreads();
        const int q4 = (lane >> 2) & 3, p4 = lane & 3;
        const int t = 16 * wid + fr; const size_t row = (size_t)ch * 128 + t;
#pragma unroll
        for (int g2 = 0; g2 < 2; ++g2) {
            const int g = 2 * gp + g2;
            f32x4 acc[8];
#pragma unroll
            for (int ct = 0; ct < 8; ++ct) acc[ct] = (f32x4){0.f, 0.f, 0.f, 0.f};
#pragma unroll
            for (int ks = 0; ks < 4; ++ks) {
                if (ks < nks) {
                    const int r1 = 32 * ks + 8 * fq + q4, r2 = r1 + 4, f1 = fswz(r1), f2 = fswz(r2);
#pragma unroll
                    for (int ct = 0; ct < 8; ++ct) {
                        const int cc = 2 * ct + (p4 >> 1);
                        const s16x4 lo = __builtin_bit_cast(s16x4, __builtin_amdgcn_ds_read_tr16_b64_v4i16((LAS v4i16_t*)(F.lds + g2 * 32768 + r1 * 256 + ((cc ^ f1) << 4) + 8 * (p4 & 1))));
                        const s16x4 hi = __builtin_bit_cast(s16x4, __builtin_amdgcn_ds_read_tr16_b64_v4i16((LAS v4i16_t*)(F.lds + g2 * 32768 + r2 * 256 + ((cc ^ f2) << 4) + 8 * (p4 & 1))));
                        const bf16x8_t vf = __builtin_shufflevector(lo, hi, 0, 1, 2, 3, 4, 5, 6, 7);
                        acc[ct] = __builtin_amdgcn_mfma_f32_16x16x32_bf16(vf, wf[g2][ks], acc[ct], 0, 0, 0);
                    }
                }
            }
            const float bias = a.b_sp[g * 128 + t];
#pragma unroll
            for (int ct = 0; ct < 8; ++ct) {
                const int c = 16 * ct + 4 * fq;
                const v2u uw = *(const v2u*)(U + row * GW + g * 128 + c);
                v2u o; o.x = pk2(bflo(uw.x) * (acc[ct][0] + bias), bfhi(uw.x) * (acc[ct][1] + bias)); o.y = pk2(bflo(uw.y) * (acc[ct][2] + bias), bfhi(uw.y) * (acc[ct][3] + bias));
                *(v2u*)(GMO + row * GW + g * 128 + c) = o;
            }
        }
    }
    __syncthreads();
}

typedef short s16x4 __attribute__((ext_vector_type(4)));
typedef short bf16x8_t __attribute__((ext_vector_type(8)));
typedef __attribute__((__vector_size__(4 * sizeof(short)))) short v4i16_t;
constexpr int ATT_K_OFF = 0, ATT_V_OFF = 65536;
constexpr int ATT_UNITS = BATCH * NH * 96;
struct AttU { int b, h, br, dsh, rho, n; };
__device__ __forceinline__ AttU att_decode(int xq, int jq, int ri) {
    AttU c; const int t3 = ri / 3, bh = xq + 8 * t3; c.br = ri - 3 * t3; c.b = bh / NH; c.h = bh - c.b * NH;
    c.dsh = 2 * c.br; const int nbsh = 5 - c.dsh; c.rho = jq >> nbsh; c.n = jq & ((1 << nbsh) - 1); return c;
}
__device__ __forceinline__ void glds1(unsigned voff, const void* sbase, unsigned lds_dst) {
    unsigned keep;
    asm volatile("s_mov_b32 %0, m0\n\ts_mov_b32 m0, %3\n\ts_nop 0\n\tglobal_load_lds_dwordx4 %1, %2\n\ts_mov_b32 m0, %0" : "=&s"(keep) : "v"(voff), "s"(sbase), "s"(lds_dst) : "memory");
}
__device__ __forceinline__ void att_issue(Frame& F, const bf16* T_, const AttU& c, unsigned lrow3k, unsigned chunk, int tile_off, int wid) {
    const char* base = (const char*)(T_ + (size_t)c.b * SEQ * AW + c.h * HD) + (size_t)c.rho * (AW * 2);
    const unsigned ldsb = (unsigned)(size_t)(F.lds + tile_off) + (unsigned)wid * 1024u;
    const unsigned voff = (lrow3k << c.dsh) + chunk;
    const int kap0 = 128 * (c.n - 1);
#pragma unroll
    for (int r = 0; r < 8; ++r) { const int kb = kap0 + 32 * r + ((c.n == 0 && r < 4) ? 128 : 0);
        glds1(voff, base + ((size_t)kb << c.dsh) * (AW * 2), ldsb + r * 8192); }
}
__device__ __forceinline__ void att_load_q(bf16x8_t (&q)[4], const void* p) {
    asm volatile("global_load_dwordx4 %0, %4, off\n\tglobal_load_dwordx4 %1, %4, off offset:64\n\tglobal_load_dwordx4 %2, %4, off offset:128\n\tglobal_load_dwordx4 %3, %4, off offset:192"
                 : "=&v"(q[0]), "=&v"(q[1]), "=&v"(q[2]), "=&v"(q[3]) : "v"(p) : "memory");
}
#define ATT_BAR() do { asm volatile("" ::: "memory"); __builtin_amdgcn_s_barrier(); asm volatile("" ::: "memory"); } while (0)
__device__ __forceinline__ void phase3_attn(Frame& F, const Args& a) {
    PHASE_IDS(F);
    const bf16* Q = (const bf16*)(a.ws + WS_Q); const bf16* Kb = (const bf16*)(a.ws + WS_K); const bf16* Vb = (const bf16*)(a.ws + WS_V);
    bf16* OP = (bf16*)(a.ws + WS_OPART); float* LSE = (float*)(a.ws + WS_LSE);
    const int lane = F.lane, wid = F.wave, fr = lane & 15, fq = lane >> 4;
    if (F.G != 256) return;
    const int xq = F.vcu >> 5, jq = F.vcu & 31;
    const int lrow = wid * 4 + fq;
    const unsigned k3k = (unsigned)lrow * (AW * 2), kch = (unsigned)((fr ^ (lrow & 15)) << 4);
    const unsigned v3k = (unsigned)((lrow & 16) | pi16(lrow & 15)) * (AW * 2), vch = (unsigned)((fr ^ fswz(lrow)) << 4);
    const int qi = 16 * wid + fr, kt0 = wid & ~1;
    __syncthreads();
    int ri = 0;
    AttU cu = att_decode(xq, jq, 0);
    bf16x8_t qf[4], qn[4];
    int tq = ((128 * cu.n + qi) << cu.dsh) + cu.rho;
    att_issue(F, Kb, cu, k3k, kch, ATT_K_OFF, wid);
    att_load_q(qn, (const bf16x8_t*)(Q + ((size_t)(cu.b * SEQ + tq) * AW + cu.h * HD)) + fq);
    att_issue(F, Vb, cu, v3k, vch, ATT_V_OFF, wid);
    for (;;) {
        const bool first = (ri == 0), lastu = (ri == 17);
        const AttU cn = att_decode(xq, jq, lastu ? ri : ri + 1);
        if (first) asm volatile("s_waitcnt vmcnt(8)" : "+v"(qn[0]), "+v"(qn[1]), "+v"(qn[2]), "+v"(qn[3]) :: "memory");
        else asm volatile("s_waitcnt vmcnt(17)" : "+v"(qn[0]), "+v"(qn[1]), "+v"(qn[2]), "+v"(qn[3]) :: "memory");
#pragma unroll
        for (int s = 0; s < 4; ++s) qf[s] = qn[s];
        ATT_BAR();
        f32x4 st[10];
#pragma unroll
        for (int i = 0; i < 10; ++i) {
            st[i] = (f32x4){0.f, 0.f, 0.f, 0.f};
#pragma unroll
            for (int s = 0; s < 4; ++s) {
                const bf16x8_t kf = *(const LAS bf16x8_t*)(F.lds + ATT_K_OFF + ((kt0 + i) * 16 + fr) * 256 + (((4 * s + fq) ^ fr) << 4));
                st[i] = __builtin_amdgcn_mfma_f32_16x16x32_bf16(kf, qf[s], st[i], 0, 0, 0);
            }
        }
        asm volatile("s_waitcnt lgkmcnt(0)" ::: "memory");
        ATT_BAR();
        att_issue(F, Kb, cn, k3k, kch, ATT_K_OFF, wid);
        const int tqn = ((128 * cn.n + qi) << cn.dsh) + cn.rho;
        att_load_q(qn, (const bf16x8_t*)(Q + ((size_t)(cn.b * SEQ + tqn) * AW + cn.h * HD)) + fq);
        const int klo = (cu.n > 0) ? qi : (qi > 128 ? qi : 128), khi = qi + 128;
        const int kk0 = 16 * kt0 + 4 * fq;
#pragma unroll
        for (int i = 0; i < 2; ++i)
#pragma unroll
            for (int r = 0; r < 4; ++r) st[i][r] = (kk0 + 16 * i + r >= klo) ? st[i][r] : -1e30f;
#pragma unroll
        for (int i = 8; i < 10; ++i)
#pragma unroll
            for (int r = 0; r < 4; ++r) st[i][r] = (kk0 + 16 * i + r <= khi) ? st[i][r] : -1e30f;
        if (cu.n == 0) {
#pragma unroll
            for (int i = 2; i < 8; ++i)
#pragma unroll
                for (int r = 0; r < 4; ++r) st[i][r] = (kk0 + 16 * i + r >= klo) ? st[i][r] : -1e30f;
        }
        float mx = -1e30f;
#pragma unroll
        for (int i = 0; i < 10; ++i) mx = fmaxf(fmaxf(mx, fmaxf(st[i][0], st[i][1])), fmaxf(st[i][2], st[i][3]));
        mx = fmaxf(mx, __shfl_xor(mx, 16)); mx = fmaxf(mx, __shfl_xor(mx, 32));
        float l = 0.f;
#pragma unroll
        for (int i = 0; i < 10; ++i)
#pragma unroll
            for (int r = 0; r < 4; ++r) { const float p = __builtin_amdgcn_exp2f(st[i][r] - mx); st[i][r] = p; l += p; }
        l += __shfl_xor(l, 16); l += __shfl_xor(l, 32);
        bf16x8_t pb[5];
#pragma unroll
        for (int i2 = 0; i2 < 5; ++i2) { const pg8::u32x4 w = pg8::pack8(st[2 * i2], st[2 * i2 + 1]); pb[i2] = __builtin_bit_cast(bf16x8_t, w); }
        if (first) asm volatile("s_waitcnt vmcnt(12)" ::: "memory"); else asm volatile("s_waitcnt vmcnt(21)" ::: "memory");
        ATT_BAR();
        const int q4 = (lane >> 2) & 3, p4 = lane & 3, R0 = pi16(4 * fq + q4), fz = fswz(R0);
        const int vb0 = ATT_V_OFF + (kt0 * 16 + R0) * 256 + 8 * (p4 & 1);
        f32x4 o[8];
#pragma unroll
        for (int dt = 0; dt < 8; ++dt) {
            const int vb = vb0 + ((((2 * dt) ^ (fz & 14)) | ((p4 >> 1) ^ (fz & 1))) << 4);
            o[dt] = (f32x4){0.f, 0.f, 0.f, 0.f};
#pragma unroll
            for (int i2 = 0; i2 < 5; ++i2) {
                const s16x4 lo = __builtin_bit_cast(s16x4, __builtin_amdgcn_ds_read_tr16_b64_v4i16((LAS v4i16_t*)(F.lds + vb + (2 * i2) * 4096)));
                const s16x4 hi = __builtin_bit_cast(s16x4, __builtin_amdgcn_ds_read_tr16_b64_v4i16((LAS v4i16_t*)(F.lds + vb + (2 * i2 + 1) * 4096)));
                const bf16x8_t vf = __builtin_shufflevector(lo, hi, 0, 1, 2, 3, 4, 5, 6, 7);
                o[dt] = __builtin_amdgcn_mfma_f32_16x16x32_bf16(vf, pb[i2], o[dt], 0, 0, 0);
            }
        }
        asm volatile("s_waitcnt lgkmcnt(0)" ::: "memory");
        ATT_BAR();
        att_issue(F, Vb, cn, v3k, vch, ATT_V_OFF, wid);
        const float inv = 1.0f / l;
        bf16* orow = OP + ((size_t)cu.br * T + (size_t)cu.b * SEQ + tq) * AW + cu.h * HD + 4 * fq;
#pragma unroll
        for (int dt = 0; dt < 8; ++dt) { v2u w; w.x = pg8::cvt_pk_bf16(o[dt][0] * inv, o[dt][1] * inv); w.y = pg8::cvt_pk_bf16(o[dt][2] * inv, o[dt][3] * inv); *(v2u*)(orow + 16 * dt) = w; }
        { float* lp = LSE + ((size_t)cu.br * T + (size_t)cu.b * SEQ + tq) * NH + cu.h; const float lv = mx + __log2f(l); if (fq == 0) *lp = lv; }
        if (lastu) break;
        cu = cn; tq = tqn; ++ri;
    }
    asm volatile("s_waitcnt vmcnt(0)" ::: "memory");
    __syncthreads();
}
__device__ __forceinline__ void phase4_combine(Frame& F, const Args& a) {
    PHASE_IDS(F);
    const int gw = F.vcu * NWAVES + F.wave, NGW = F.G * NWAVES;
    const bf16* OP = (const bf16*)(a.ws + WS_OPART); const float* LSE = (const float*)(a.ws + WS_LSE); unsigned char* CAT8 = a.ws + WS_CAT;
    const bf16* GMO = (const bf16*)(a.ws + WS_GMO);
    for (int m = gw; m < T; m += NGW) {
        f32x4 r[4][2]; float am = 0.f, am2 = 0.f;
#pragma unroll
        for (int j = 0; j < 3; ++j) {
            const int ch = F.lane + 64 * j, hd = ch >> 4;
            const float l0 = LSE[((size_t)0 * T + m) * NH + hd], l1 = LSE[((size_t)1 * T + m) * NH + hd], l2 = LSE[((size_t)2 * T + m) * NH + hd];
            const float mx = fmaxf(l0, fmaxf(l1, l2)), e0 = __builtin_amdgcn_exp2f(l0 - mx), e1 = __builtin_amdgcn_exp2f(l1 - mx), e2 = __builtin_amdgcn_exp2f(l2 - mx), inv = 1.0f / (e0 + e1 + e2);
            const v4u a0 = *((const v4u*)(OP + ((size_t)0 * T + m) * AW) + ch), a1 = *((const v4u*)(OP + ((size_t)1 * T + m) * AW) + ch), a2 = *((const v4u*)(OP + ((size_t)2 * T + m) * AW) + ch);
            const float w0 = e0 * inv, w1 = e1 * inv, w2 = e2 * inv;
            r[j][0] = (f32x4){w0 * bflo(a0.x) + w1 * bflo(a1.x) + w2 * bflo(a2.x), w0 * bfhi(a0.x) + w1 * bfhi(a1.x) + w2 * bfhi(a2.x), w0 * bflo(a0.y) + w1 * bflo(a1.y) + w2 * bflo(a2.y), w0 * bfhi(a0.y) + w1 * bfhi(a1.y) + w2 * bfhi(a2.y)};
            r[j][1] = (f32x4){w0 * bflo(a0.z) + w1 * bflo(a1.z) + w2 * bflo(a2.z), w0 * bfhi(a0.z) + w1 * bfhi(a1.z) + w2 * bfhi(a2.z), w0 * bflo(a0.w) + w1 * bflo(a1.w) + w2 * bflo(a2.w), w0 * bfhi(a0.w) + w1 * bfhi(a1.w) + w2 * bfhi(a2.w)};
        }
        { const v4u gm = *((const v4u*)(GMO + (size_t)m * GW) + F.lane);
            r[3][0] = (f32x4){bflo(gm.x), bfhi(gm.x), bflo(gm.y), bfhi(gm.y)}; r[3][1] = (f32x4){bflo(gm.z), bfhi(gm.z), bflo(gm.w), bfhi(gm.w)}; }
#pragma unroll
        for (int j = 0; j < 3; ++j)
#pragma unroll
            for (int q = 0; q < 2; ++q) am = fmaxf(fmaxf(am, fmaxf(fabsf(r[j][q][0]), fabsf(r[j][q][1]))), fmaxf(fabsf(r[j][q][2]), fabsf(r[j][q][3])));
#pragma unroll
        for (int q = 0; q < 2; ++q) am2 = fmaxf(fmaxf(am2, fmaxf(fabsf(r[3][q][0]), fabsf(r[3][q][1]))), fmaxf(fabsf(r[3][q][2]), fabsf(r[3][q][3])));
        am = fmaxf(wave_max(am), 1e-20f); am2 = fmaxf(wave_max(am2), 1e-20f);
#pragma unroll
        for (int j = 0; j < 4; ++j) { const float qs = 127.0f / (j < 3 ? am : am2);
            v2u o; o.x = q8x4(r[j][0][0], r[j][0][1], r[j][0][2], r[j][0][3], qs); o.y = q8x4(r[j][1][0], r[j][1][1], r[j][1][2], r[j][1][3], qs);
            *((v2u*)(CAT8 + (size_t)m * D) + F.lane + 64 * j) = o; }
        if (F.lane == 0) { ((float*)(a.ws + WS_RSCAT))[m] = am2 * (1.0f / 127.0f); ((float*)(a.ws + WS_RSRATIO))[m] = fminf(am / am2, 1024.0f); }
    }
}

#define P5_BAR() asm volatile("s_waitcnt lgkmcnt(0)\n\ts_barrier" ::: "memory")
__device__ __forceinline__ void phase5(Frame& F, const Args& a) {
    PHASE_IDS(F);
    const float* mod = (const float*)(a.ws + WS_MOD); const bf16* Y1 = (const bf16*)(a.ws + WS_Y1); bf16* X1 = (bf16*)(a.ws + WS_X1);
    unsigned char* H8 = a.ws + WS_H8;
    int* TOPI = (int*)(a.ws + WS_TOPI); float* GATE = (float*)(a.ws + WS_GATE); int* RANK = (int*)(a.ws + WS_RANK);
    constexpr int HS = D + 4;
    LAS float* hs = (LAS float*)(F.lds);
    LAS float* part = (LAS float*)(F.lds + 67584);
    LAS float* lgs = (LAS float*)(F.lds + 67584 + 16384);
    LAS int* hist = (LAS int*)(F.lds + 90112);
    LAS int* gbase = (LAS int*)(F.lds + 90112 + 128);
    LAS int* asg_e = (LAS int*)(F.lds + 91136);
    LAS int* asg_r = (LAS int*)(F.lds + 91136 + 4096);
    LAS int* asg_m = (LAS int*)(F.lds + 91136 + 8192);
    LAS float* prm = (LAS float*)(F.lds + 104448);
    const int lane = F.lane, wid = F.wave;
    if (F.tid < 32) hist[F.tid] = 0;
    const int rows_per_wg = T / F.G, row_base = F.vcu * rows_per_wg;
    { const float* mb0 = mod + (size_t)(row_base / SEQ) * (6 * D);
        for (int i = F.tid; i < D / 4; i += NWAVES * 64) { ((LAS f32x4*)prm)[i] = ((const f32x4*)a.ln1_g)[i]; ((LAS f32x4*)(prm + D))[i] = ((const f32x4*)a.ln1_b)[i];
            ((LAS f32x4*)(prm + 2 * D))[i] = ((const f32x4*)(mb0 + 3 * D))[i]; ((LAS f32x4*)(prm + 3 * D))[i] = ((const f32x4*)(mb0 + 4 * D))[i] + 1.0f; } }
    int li = 0;
    float wB[16][4][2];
    { const float* wp = a.rw + (size_t)(wid * 256 + 4 * (lane >> 4)) * NE + (lane & 15);
#pragma unroll
        for (int g = 0; g < 16; ++g)
#pragma unroll
            for (int t = 0; t < 4; ++t) { wB[g][t][0] = wp[(size_t)(16 * g + t) * NE]; wB[g][t][1] = wp[(size_t)(16 * g + t) * NE + 16]; } }
    v2u ynx[8];
#pragma unroll
    for (int j = 0; j < 8; ++j) ynx[j] = *((const v2u*)(Y1 + (size_t)(row_base + wid) * D) + lane + 64 * j);
    for (int sb = 0; sb < rows_per_wg; sb += 8, ++li) {
        const int m = row_base + sb + wid;
        P5_BAR();
        {
            f32x4 v[8]; float s = 0.f;
#pragma unroll
            for (int j = 0; j < 8; ++j) { const v2u yw = ynx[j]; v[j] = (f32x4){bflo(yw.x), bfhi(yw.x), bflo(yw.y), bfhi(yw.y)}; s += (v[j].x + v[j].y) + (v[j].z + v[j].w); }
            float mean = wave_sum(s) * (1.f / D); float s2 = 0.f;
#pragma unroll
            for (int j = 0; j < 8; ++j) { v[j] = v[j] - mean; s2 += (v[j].x * v[j].x + v[j].y * v[j].y) + (v[j].z * v[j].z + v[j].w * v[j].w); }
            float rstd = 1.f / sqrtf(wave_sum(s2) * (1.f / D) + LN_EPS);
            v2u* xo = (v2u*)(X1 + (size_t)m * D) + lane;
            s = 0.f;
#pragma unroll
            for (int j = 0; j < 8; ++j) { asm volatile("" ::: "memory"); const f32x4 gg = *((const LAS f32x4*)prm + lane + 64 * j), bb = *((const LAS f32x4*)(prm + D) + lane + 64 * j);
                v[j] = v[j] * rstd * gg + bb; v2u xw; xw.x = pk2(v[j].x, v[j].y); xw.y = pk2(v[j].z, v[j].w); xo[64 * j] = xw; s += (v[j].x + v[j].y) + (v[j].z + v[j].w); }
            mean = wave_sum(s) * (1.f / D); s2 = 0.f;
#pragma unroll
            for (int j = 0; j < 8; ++j) { v[j] = v[j] - mean; s2 += (v[j].x * v[j].x + v[j].y * v[j].y) + (v[j].z * v[j].z + v[j].w * v[j].w); }
            rstd = 1.f / sqrtf(wave_sum(s2) * (1.f / D) + LN_EPS);
            unsigned* o4 = (unsigned*)(H8 + (size_t)m * D) + lane; float am = 0.f;
#pragma unroll
            for (int j = 0; j < 8; ++j) { asm volatile("" ::: "memory"); const f32x4 sh = *((const LAS f32x4*)(prm + 2 * D) + lane + 64 * j), sc1 = *((const LAS f32x4*)(prm + 3 * D) + lane + 64 * j);
                v[j] = v[j] * rstd * sc1 + sh; am = fmaxf(fmaxf(am, fmaxf(fabsf(v[j].x), fabsf(v[j].y))), fmaxf(fabsf(v[j].z), fabsf(v[j].w)));
                *((LAS f32x4*)(hs + wid * HS) + lane + 64 * j) = v[j]; }
            am = fmaxf(wave_max(am), 1e-20f);
            const float qs = 127.0f / am;
#pragma unroll
            for (int j = 0; j < 8; ++j) o4[64 * j] = q8x4(v[j].x, v[j].y, v[j].z, v[j].w, qs);
            if (lane == 0) ((float*)(a.ws + WS_RSH2))[m] = am * (1.0f / 127.0f);
        }
        LDS_WAIT();
        P5_BAR();
        {
            const int q = lane >> 4, j = lane & 15;
            f32x4 acc0 = (f32x4){0.f, 0.f, 0.f, 0.f}, acc1 = (f32x4){0.f, 0.f, 0.f, 0.f};
            const LAS float* hp = hs + (lane & 7) * HS + wid * 256 + 4 * q;
#pragma unroll
            for (int g = 0; g < 16; ++g) { const f32x4 av = *(const LAS f32x4*)(hp + 16 * g);
#pragma unroll
                for (int t = 0; t < 4; ++t) { acc0 = __builtin_amdgcn_mfma_f32_16x16x4f32(av[t], wB[g][t][0], acc0, 0, 0, 0); acc1 = __builtin_amdgcn_mfma_f32_16x16x4f32(av[t], wB[g][t][1], acc1, 0, 0, 0); } }
            if (q < 2) {
#pragma unroll
                for (int r = 0; r < 4; ++r) { part[(wid * 8 + 4 * q + r) * 32 + j] = acc0[r]; part[(wid * 8 + 4 * q + r) * 32 + 16 + j] = acc1[r]; } }
        }
        if (sb + 8 < rows_per_wg) {
#pragma unroll
            for (int j = 0; j < 8; ++j) ynx[j] = *((const v2u*)(Y1 + (size_t)(m + 8) * D) + lane + 64 * j);
        }
        LDS_WAIT();
        P5_BAR();
        if (F.tid < 256) { const int r = F.tid >> 5, e = F.tid & 31; float sum = a.rb[e];
#pragma unroll
            for (int k = 0; k < 8; ++k) sum += part[(k * 8 + r) * 32 + e];
            lgs[r * 32 + e] = sum; }
        LDS_WAIT();
        P5_BAR();
        {
            float lg[32];
#pragma unroll
            for (int q = 0; q < 8; ++q) { const f32x4 t4 = *(const LAS f32x4*)(lgs + wid * 32 + 4 * q); lg[4 * q] = t4.x; lg[4 * q + 1] = t4.y; lg[4 * q + 2] = t4.z; lg[4 * q + 3] = t4.w; }
            float tv[4]; int ti[4];
#pragma unroll
            for (int k = 0; k < 4; ++k) { float best = -3.0e38f; int bi = 0;
#pragma unroll
                for (int e = 0; e < 32; ++e) { const bool gt = lg[e] > best; best = gt ? lg[e] : best; bi = gt ? e : bi; }
                tv[k] = best; ti[k] = bi;
#pragma unroll
                for (int e = 0; e < 32; ++e) lg[e] = (e == bi) ? -3.0e38f : lg[e]; }
            const float e1 = __expf(tv[1] - tv[0]), e2 = __expf(tv[2] - tv[0]), e3 = __expf(tv[3] - tv[0]), inv = 1.0f / (1.0f + e1 + e2 + e3);
            if (lane < 4) {
                const int k = lane; const int e = k == 0 ? ti[0] : k == 1 ? ti[1] : k == 2 ? ti[2] : ti[3];
                const float gt = (k == 0 ? 1.0f : k == 1 ? e1 : k == 2 ? e2 : e3) * inv;
                TOPI[m * 4 + k] = e; GATE[m * 4 + k] = gt;
                const int lr = __hip_atomic_fetch_add(&hist[e], 1, __ATOMIC_RELAXED, __HIP_MEMORY_SCOPE_WORKGROUP);
                const int idx = (li * NWAVES + wid) * 4 + k;
                asg_e[idx] = e; asg_r[idx] = lr; asg_m[idx] = m * 4 + k;
            }
        }
    }
    __syncthreads();
    if (F.tid < 32) gbase[F.tid] = (int)__hip_atomic_fetch_add(F.ctl + CW_CNT + F.tid * CW_CNT_STRIDE, (unsigned)hist[F.tid], RLX_AGENT);
    __syncthreads();
    const int nasg = li * NWAVES * 4;
    for (int i = F.tid; i < nasg; i += NWAVES * 64) RANK[asg_m[i]] = gbase[asg_e[i]] + asg_r[i];
    __syncthreads();
}

__device__ __forceinline__ void phase6(Frame& F, const Args& a) {
    PHASE_IDS(F);
    LAS int* tb = (LAS int*)(F.lds);
    LAS int* cn = (LAS int*)(F.lds + 256);
    const int* TOPI = (const int*)(a.ws + WS_TOPI); const int* RANK = (const int*)(a.ws + WS_RANK);
    int* TSLOT = (int*)(a.ws + WS_TSLOT); int* TILEE = (int*)(a.ws + WS_TILEE);
    if (F.tid < 32) cn[F.tid] = (int)__hip_atomic_load(F.ctl + CW_CNT + F.tid * CW_CNT_STRIDE, RLX_AGENT);
    __syncthreads();
    if (F.tid == 0) { int acc = 0; for (int e = 0; e < 32; ++e) { tb[e] = acc; acc += (cn[e] + 255) >> 8; } tb[32] = acc; }
    __syncthreads();
    if (blockIdx.x == 0) {
        if (F.tid < 32) { const int e = F.tid; for (int i = tb[e]; i < tb[e + 1]; ++i) TILEE[i] = e; }
        if (F.tid == 0) TILEE[512] = tb[32];
    }
    int* SLOTTOK = (int*)(a.ws + WS_SLOTTOK); float* RSSLOT = (float*)(a.ws + WS_RSSLOT); const float* RSH2 = (const float*)(a.ws + WS_RSH2);
    if (blockIdx.x < 32) { const int e = blockIdx.x; for (int s_ = cn[e] + F.tid; s_ < ((tb[e + 1] - tb[e]) << 8); s_ += NWAVES * 64) { SLOTTOK[(tb[e] << 8) + s_] = 0; RSSLOT[(tb[e] << 8) + s_] = RSH2[0]; } }
    for (int i = blockIdx.x * (NWAVES * 64) + F.tid; i < T * TOPK; i += F.G * NWAVES * 64) {
        const int e = TOPI[i], slot = (tb[e] << 8) + RANK[i];
        SLOTTOK[slot] = i >> 2; TSLOT[i] = slot; RSSLOT[slot] = RSH2[i >> 2];
    }
    __syncthreads();
}

__device__ __forceinline__ void phase9(Frame& F, const Args& a) {
    PHASE_IDS(F);
    const int gw = F.vcu * NWAVES + F.wave, NGW = F.G * NWAVES;
    const float* mod = (const float*)(a.ws + WS_MOD); const unsigned char* YS = (const unsigned char*)(a.ws + WS_YS);
    const int* TSLOT = (const int*)(a.ws + WS_TSLOT); const float* GATE = (const float*)(a.ws + WS_GATE); const bf16* X1 = (const bf16*)(a.ws + WS_X1);
    LAS float* prm = (LAS float*)(F.lds);
    for (int i = F.tid; i < D / 4; i += NWAVES * 64) { ((LAS f32x4*)prm)[i] = ((const f32x4*)a.ln2_g)[i]; ((LAS f32x4*)(prm + D))[i] = ((const f32x4*)a.ln2_b)[i];
#pragma unroll
        for (int b = 0; b < BATCH; ++b) ((LAS f32x4*)(prm + (2 + b) * D))[i] = ((const f32x4*)(mod + (size_t)b * (6 * D) + 5 * D))[i]; }
    __syncthreads();
    int sln[4] = {0, 0, 0, 0}; float gtn[4] = {0.f, 0.f, 0.f, 0.f};
    if (gw < T) {
#pragma unroll
        for (int k = 0; k < 4; ++k) { sln[k] = TSLOT[gw * 4 + k]; gtn[k] = GATE[gw * 4 + k]; } }
    for (int m = gw; m < T; m += NGW) {
        f32x4* xo = (f32x4*)(a.out + (size_t)m * D) + F.lane; const v2u* xi = (const v2u*)(X1 + (size_t)m * D) + F.lane;
        const LAS float* mb = prm + (2 + m / SEQ) * D;
        int sl[4]; float gt[4];
#pragma unroll
        for (int k = 0; k < 4; ++k) { sl[k] = sln[k]; gt[k] = gtn[k] * (1.0f / SC_YS); }
        if (m + NGW < T) {
#pragma unroll
            for (int k = 0; k < 4; ++k) { sln[k] = TSLOT[(m + NGW) * 4 + k]; gtn[k] = GATE[(m + NGW) * 4 + k]; } }
        f32x4 v[8]; float s = 0.f;
#pragma unroll
        for (int j = 0; j < 8; ++j) {
            f32x4 f = (f32x4){0.f, 0.f, 0.f, 0.f};
#pragma unroll
            for (int k = 0; k < 4; ++k) { const int w = *((const int*)(YS + (size_t)sl[k] * D) + F.lane + 64 * j);
                const auto lo = __builtin_amdgcn_cvt_pk_f32_fp8(w, false), hi = __builtin_amdgcn_cvt_pk_f32_fp8(w, true);
                f += (f32x4){lo[0], lo[1], hi[0], hi[1]} * gt[k]; }
            const f32x4 g2 = *((const LAS f32x4*)mb + F.lane + 64 * j);
            const v2u xw = xi[64 * j];
            v[j] = (f32x4){bflo(xw.x), bfhi(xw.x), bflo(xw.y), bfhi(xw.y)} * DN_ALPHA + g2 * f; s += (v[j].x + v[j].y) + (v[j].z + v[j].w); }
        const float mean = wave_sum(s) * (1.f / D); float s2 = 0.f;
#pragma unroll
        for (int j = 0; j < 8; ++j) { v[j] = v[j] - mean; s2 += (v[j].x * v[j].x + v[j].y * v[j].y) + (v[j].z * v[j].z + v[j].w * v[j].w); }
        const float rstd = 1.f / sqrtf(wave_sum(s2) * (1.f / D) + LN_EPS);
#pragma unroll
        for (int j = 0; j < 8; ++j) { const f32x4 gg = *((const LAS f32x4*)prm + F.lane + 64 * j), bb = *((const LAS f32x4*)(prm + D) + F.lane + 64 * j);
            xo[64 * j] = v[j] * rstd * gg + bb; }
    }
}

__global__ void __launch_bounds__(NWAVES * 64, 2) fwd_kernel(Args args) {
    extern __shared__ __attribute__((aligned(16))) unsigned char lds[];
    Frame F;
    F.lds = (LAS unsigned char*)lds;
    F.MISC = (volatile LAS unsigned*)(F.lds + MISC_OFF);
    F.tid = threadIdx.x; F.lane = F.tid & 63; F.wave = __builtin_amdgcn_readfirstlane(F.tid >> 6);
    F.G = gridDim.x; { const int bx = blockIdx.x; F.vcu = (F.G % 8 == 0) ? (bx % 8) * (F.G / 8) + bx / 8 : bx; }
    unsigned char* ws = args.ws;
    F.ctl = (unsigned*)(ws + WS_CTL);
    for (int u = F.tid; u < (LDS_BYTES - LDSCTL_OFF) / 4; u += NWAVES * 64) ((LAS unsigned*)(F.lds + LDSCTL_OFF))[u] = 0u;
    __syncthreads();
    XcdBarrier bar; bar.bar = F.ctl + CW_BAR; bar.x = 0; bar.st = nullptr;
    if (N_LAUNCHES != PER_PHASE) bar = xcd_barrier_post(F.ctl + CW_BAR, F.MISC + 8);
#define GRID_BAR() do { if (N_LAUNCHES != PER_PHASE) xcd_barrier(bar); } while (0)
    const int lo = args.ph_lo, hi = args.ph_hi;
#define IN(k) (lo <= (k) && (k) < hi)
#define BOTH(k) (IN(k) && IN((k) + 1))

    if (IN(0)) { phase0(F, args); if (BOTH(0)) GRID_BAR(); }
    if (IN(1)) { phase1(F, args); if (BOTH(1)) GRID_BAR(); }
    if (IN(2)) {
        pg8::Gemm g{ws + WS_H, ws + WS_WIN, D, 0, nullptr, (const float*)(ws + WS_RSH)};
        pg8::Order S; S.init(T / 256, NPROJ / 256, F.G, (int)blockIdx.x, nullptr, WGM_IN);
        static_assert(WS_K - WS_Q == (48u << 20) && WS_V - WS_K == (48u << 20) && WS_VG - WS_U == (16u << 20), "EpiInProj strides");
        pg8::EpiInProj E{ws, WS_Q, WS_U, (const _Float16*)(ws + WS_ROPE), 1.0f / SC_WIN};
        const bool conv_first = (blockIdx.x & 8) != 0;
        if (conv_first) conv_dyn(F, args, CONV_NCHUNK / 2);
        pg8::gemm_phase<pg8::EpiInProj, false, 2>(F.lds + RING_OFF, g, S, E);
        conv_dyn(F, args, CONV_NCHUNK);
        if (BOTH(2)) GRID_BAR();
    }
    if (IN(3)) { phase3_gmlp(F, args); phase3_attn(F, args); if (BOTH(3)) GRID_BAR(); }
    if (IN(4)) { phase4_combine(F, args); if (BOTH(4)) GRID_BAR(); }
    if (IN(5)) {
        pg8::Gemm g{ws + WS_CAT, ws + WS_WOUT, D, 0, nullptr, (const float*)(ws + WS_RSCAT), (const float*)(ws + WS_RSRATIO), AW / 128};
        pg8::Order S; S.init(T / 256, D / 256, F.G, (int)blockIdx.x, nullptr, WGM_OUT);
        pg8::EpiOutProj E{args.x, (const float*)(ws + WS_MOD), (bf16*)(ws + WS_Y1), 1.0f / SC_WOUT};
        pg8::gemm_phase<pg8::EpiOutProj, false, 2, true>(F.lds + RING_OFF, g, S, E);
        if (BOTH(5)) GRID_BAR();
    }
    if (IN(6)) { phase5(F, args); if (BOTH(6)) GRID_BAR(); }
    if (IN(7)) { phase6(F, args); if (BOTH(7)) GRID_BAR(); }
    if (IN(8)) {
        const int* TILEE = (const int*)(ws + WS_TILEE);
        const int ntiles = __builtin_amdgcn_readfirstlane(TILEE[512]);
        pg8::Gemm g{ws + WS_H8, ws + WS_WGU, D, (size_t)2 * DFF * D, (const int*)(ws + WS_SLOTTOK), (const float*)(ws + WS_RSSLOT)};
        pg8::Order S; S.init(ntiles, 2 * DFF / 256, F.G, (int)blockIdx.x, TILEE, WGM_GU);
        pg8::EpiSwiglu E{args.bgu, ws + WS_ACT, 1.0f / SC_WGU, SC_ACT};
        pg8::gemm_phase<pg8::EpiSwiglu, true, 2>(F.lds + RING_OFF, g, S, E);
        if (BOTH(8)) GRID_BAR();
    }
    if (IN(9)) {
        const int* TILEE = (const int*)(ws + WS_TILEE);
        const int ntiles = __builtin_amdgcn_readfirstlane(TILEE[512]);
        pg8::Gemm g{ws + WS_ACT, ws + WS_WD, DFF, (size_t)D * DFF, nullptr};
        pg8::Order S; S.init(ntiles, D / 256, F.G, (int)blockIdx.x, TILEE, WGM_DN);
        pg8::EpiDown E{args.bd, ws + WS_YS, 1.0f / (SC_ACT * SC_WD), SC_YS};
        pg8::gemm_phase<pg8::EpiDown, false, true>(F.lds + RING_OFF, g, S, E);
        if (BOTH(9)) GRID_BAR();
    }
    if (IN(10)) { phase9(F, args); }
#undef IN
#undef BOTH
}

extern "C" void kernel_launch(void* const* d_in, const int* in_sizes, int n_in, void* d_out, int out_size, void* d_ws, size_t ws_size, hipStream_t stream) {
    static int grid = 0;
    if (grid == 0) {
        if (n_in != 21 || in_sizes[0] != T * D || out_size != T * D || ws_size < WS_END) { fprintf(stderr, "kernel_launch: unexpected shapes (n_in %d, ws %zu)\n", n_in, ws_size); grid = -1; return; }
        if (hipFuncSetAttribute((const void*)fwd_kernel, hipFuncAttributeMaxDynamicSharedMemorySize, LDS_BYTES) != hipSuccess) { fprintf(stderr, "kernel_launch: hipFuncSetAttribute failed\n"); grid = -1; return; }
        int per_cu = 0;
        if (hipOccupancyMaxActiveBlocksPerMultiprocessor(&per_cu, (const void*)fwd_kernel, NWAVES * 64, LDS_BYTES) != hipSuccess || per_cu < 1) fprintf(stderr, "kernel_launch: occupancy query says %d\n", per_cu);
        (void)hipGetLastError();
        grid = 256;
    }
    if (grid < 0) return;
    if (hipMemsetAsync((char*)d_ws + WS_CTL, 0, CTL_ZERO_BYTES, stream) != hipSuccess) return;
    Args a{};
    a.x = (const float*)d_in[0]; a.c = (const float*)d_in[1]; a.pos = (const int*)d_in[2]; a.ada_w = (const float*)d_in[3]; a.ada_b = (const float*)d_in[4];
    a.w_in = (const float*)d_in[5]; a.w_sp = (const float*)d_in[6]; a.b_sp = (const float*)d_in[7]; a.gln_g = (const float*)d_in[8]; a.gln_b = (const float*)d_in[9];
    a.w_out = (const float*)d_in[10]; a.ln1_g = (const float*)d_in[11]; a.ln1_b = (const float*)d_in[12]; a.rw = (const float*)d_in[13]; a.rb = (const float*)d_in[14];
    a.wgu = (const float*)d_in[15]; a.bgu = (const float*)d_in[16]; a.wd = (const float*)d_in[17]; a.bd = (const float*)d_in[18]; a.ln2_g = (const float*)d_in[19]; a.ln2_b = (const float*)d_in[20];
    a.out = (float*)d_out; a.ws = (unsigned char*)d_ws;
    if (N_LAUNCHES == 1) { a.ph_lo = 0; a.ph_hi = PER_PHASE; hipLaunchKernelGGL(fwd_kernel, dim3(grid), dim3(NWAVES * 64), LDS_BYTES, stream, a); }
    else for (int p = 0; p < PER_PHASE; ++p) { a.ph_lo = p; a.ph_hi = p + 1; hipLaunchKernelGGL(fwd_kernel, dim3(grid), dim3(NWAVES * 64), LDS_BYTES, stream, a); }
}
```

```cpp
#include <hip/hip_runtime.h>
#include <cstdio>
#include <cstdint>

#ifndef MK_N_LAUNCHES
#define MK_N_LAUNCHES 1
#endif

constexpr int BATCH = 4, SEQ = 4096, T = BATCH * SEQ, D = 2048;
constexpr int AW = 1536, NH = 12, HD = 128, GW = 512, NPROJ = 3 * AW + 2 * GW;
constexpr int NE = 32, TOPK = 4, DFF = 2048;
constexpr int MAXTILES = T * TOPK / 256 + NE;
constexpr float LN_EPS = 1e-5f;
constexpr float DN_ALPHA = 1.189207115002721f;
constexpr float QSCALE = 0.08838834764831845f * 1.4426950408889634f;

namespace pg8 {
#define PG8_LAS __attribute__((address_space(3)))
typedef unsigned short bf16_t;
typedef short bf16x8 __attribute__((ext_vector_type(8)));
typedef float f32x4 __attribute__((ext_vector_type(4)));
typedef float f32x2 __attribute__((ext_vector_type(2)));
typedef unsigned u32x4 __attribute__((ext_vector_type(4)));
constexpr int BM = 256, BK = 64, HALF = 128, HTB = HALF * BK * 2, STAGE_BYTES = 8 * HTB, NXCD = 8, WGM = 4;

__host__ __device__ __forceinline__ int lds_byte(int r, int c) { const int st = (r >> 4) * 2 + (c >> 5), rr = r & 15, cc = c & 31, ob = rr * 64 + cc * 2; return st * 1024 + (ob ^ (((ob >> 9) & 1) << 5)); }
__host__ __device__ __forceinline__ void stage_rc(int b, int& R, int& C) { const int st = b / 1024, sb = b % 1024, swz = sb ^ (((sb >> 9) & 1) << 5); R = (st >> 1) * 16 + swz / 64; C = (st & 1) * 32 + (swz % 64) / 2; }
__host__ __device__ __forceinline__ int perm32(int rho) { const int n = rho >> 4, i = rho & 15; return 8 * (i >> 2) + 4 * n + (i & 3); }

struct Unit { int pm, pn, e; };
struct Gemm { const void* A; const void* Bt; int rowbytes; size_t bstride; const int* rowidx; const float* rowscale = nullptr; const float* splitratio = nullptr; int split_t = -1; };
typedef int v8i_t __attribute__((ext_vector_type(8)));
typedef int v4i_t __attribute__((ext_vector_type(4)));

struct Order {
    int nM, nN, nwg, G, c, wgm, gap_at = 0x7fffffff, gap = 0; const int* tile_e;
    __device__ void init(int nM_, int nN_, int G_, int c_, const int* te, int wgm_) { nM = nM_; nN = nN_; nwg = nM * nN; G = G_; c = c_; tile_e = te; wgm = wgm_; }
    __device__ bool next(int i, Unit& u) const {
        const long L = (long)i * G + c; if (L >= nwg) return false;
        int wgid = (int)L; { const int q = nwg / NXCD, r = nwg % NXCD, xcd = wgid % NXCD, off = wgid / NXCD; wgid = (xcd < r ? xcd * (q + 1) : r * (q + 1) + (xcd - r) * q) + off; }
        const int nig = wgm * nN, gid = wgid / nig, fm = gid * wgm, gsz = (nM - fm) < wgm ? (nM - fm) : wgm;
        u.pm = fm + ((wgid % nig) % gsz); u.pn = (wgid % nig) / gsz; if (u.pn >= gap_at) u.pn += gap; u.e = tile_e ? tile_e[u.pm] : 0; return true;
    }
};

__device__ __forceinline__ unsigned cvt_pk_bf16(float lo, float hi) { unsigned r; asm volatile("v_cvt_pk_bf16_f32 %0, %1, %2" : "=v"(r) : "v"(lo), "v"(hi)); return r; }
__device__ __forceinline__ f32x2 gelu_pk(f32x2 v) {
    const f32x2 av = __builtin_elementwise_abs(v), d = av * 0.2316418882f + 1.0f;
    f32x2 t; t.x = __builtin_amdgcn_rcpf(d.x); t.y = __builtin_amdgcn_rcpf(d.y);
    f32x2 q = t * 0.5307027145f + (-0.7265760135f); q = q * t + 0.7107068705f; q = q * t + (-0.142248368f); q = q * t + 0.127414796f; q = q * t;
    const f32x2 s = (v * v) * (-0.72134752044f);
    f32x2 e; e.x = __builtin_amdgcn_exp2f(s.x); e.y = __builtin_amdgcn_exp2f(s.y);
    const f32x2 m = v * (q * e), r = v - m;
    f32x2 o; o.x = v.x < 0.f ? m.x : r.x; o.y = v.y < 0.f ? m.y : r.y; return o;
}
__device__ __forceinline__ f32x4 gelu4(f32x4 v) { const f32x2 a = gelu_pk((f32x2){v[0], v[1]}), b = gelu_pk((f32x2){v[2], v[3]}); return (f32x4){a.x, a.y, b.x, b.y}; }
__device__ __forceinline__ u32x4 pack8(f32x4 v0, f32x4 v1) { u32x4 w; w.x = cvt_pk_bf16(v0[0], v0[1]); w.y = cvt_pk_bf16(v0[2], v0[3]); w.z = cvt_pk_bf16(v1[0], v1[1]); w.w = cvt_pk_bf16(v1[2], v1[3]); return w; }

__device__ __forceinline__ void swap16(int& x, int& y) { const auto r = __builtin_amdgcn_permlane16_swap((unsigned)x, (unsigned)y, false, false); x = (int)r[0]; y = (int)r[1]; }
struct EpiInProj {
    static constexpr bool PERM = true;
    unsigned char* ws; size_t off_q, off_u; const _Float16* rope; float descale;
    __device__ __forceinline__ void operator()(const f32x4 (&acc)[2][2][4][2], const Unit& u, int wr, int wc, int fr, int fq) const {
        const int row0 = u.pm * BM + wr * 64 + fr, pn = u.pn;
        if (pn < 12) {
            const int tq = pn >= 6 ? 1 : 0;
            bf16_t* dst = (bf16_t*)(ws + off_q + (size_t)tq * (48u << 20)); const float sc = (tq ? 1.0f : QSCALE) * descale;
            const int i0 = 32 * (wc & 1) + 8 * fq, col = (pn - 6 * tq) * 256 + (wc >> 1) * 128 + i0;
            typedef _Float16 h16x8 __attribute__((ext_vector_type(8)));
            h16x8 cs[2][4][2];
#pragma unroll
            for (int ai = 0; ai < 2; ++ai)
#pragma unroll
                for (int m = 0; m < 4; ++m) { const h16x8* p = (const h16x8*)(rope + ((size_t)(row0 + ai * HALF + m * 16) * 64 + i0) * 2); cs[ai][m][0] = p[0]; cs[ai][m][1] = p[1]; }
#pragma unroll
            for (int ai = 0; ai < 2; ++ai)
#pragma unroll
                for (int m = 0; m < 4; ++m) {
                    const int row = row0 + ai * HALF + m * 16;
                    f32x4 o1[2], o2[2];
#pragma unroll
                    for (int n = 0; n < 2; ++n) { const f32x4 av = acc[ai][0][m][n], bv = acc[ai][1][m][n]; const h16x8 c = cs[ai][m][n];
#pragma unroll
                        for (int j = 0; j < 4; ++j) { const float cc = (float)c[2 * j], ss = (float)c[2 * j + 1];
                            o1[n][j] = (av[j] * cc - bv[j] * ss) * sc; o2[n][j] = (bv[j] * cc + av[j] * ss) * sc; } }
                    bf16_t* p = dst + (size_t)row * AW + col;
                    *(u32x4*)p = pack8(o1[0], o1[1]); *(u32x4*)(p + 64) = pack8(o2[0], o2[1]);
                }
        } else if (pn < 18) {
            bf16_t* dst = (bf16_t*)(ws + off_q + (size_t)2 * (48u << 20));
            const int col = (pn - 12) * 256 + wc * 32 + 8 * fq;
#pragma unroll
            for (int ai = 0; ai < 2; ++ai)
#pragma unroll
                for (int m = 0; m < 4; ++m) { bf16_t* rowp = dst + (size_t)(row0 + ai * HALF + m * 16) * AW + col;
#pragma unroll
                    for (int bj = 0; bj < 2; ++bj) *(u32x4*)(rowp + bj * HALF) = pack8(acc[ai][bj][m][0] * descale, acc[ai][bj][m][1] * descale); }
        } else {
            const int tu = (pn - 18) >> 1;
            bf16_t* dst = (bf16_t*)(ws + off_u + (size_t)tu * (16u << 20));
            const int col = ((pn - 18) & 1) * 256 + wc * 32 + 8 * fq;
#pragma unroll
            for (int ai = 0; ai < 2; ++ai)
#pragma unroll
                for (int m = 0; m < 4; ++m) { bf16_t* rowp = dst + (size_t)(row0 + ai * HALF + m * 16) * GW + col;
#pragma unroll
                    for (int bj = 0; bj < 2; ++bj) *(u32x4*)(rowp + bj * HALF) = pack8(gelu4(acc[ai][bj][m][0] * descale), gelu4(acc[ai][bj][m][1] * descale)); }
        }
    }
};
struct EpiOutProj {
    static constexpr bool PERM = true;
    const float* x; const float* mod; bf16_t* Y; float descale;
    __device__ __forceinline__ void operator()(const f32x4 (&acc)[2][2][4][2], const Unit& u, int wr, int wc, int fr, int fq) const {
        const int row0 = u.pm * BM + wr * 64 + fr, col0 = u.pn * BM + wc * 32 + 8 * fq;
        const float* g1 = mod + (size_t)(u.pm / (SEQ / BM)) * (6 * D) + 2 * D;
        f32x4 gv[2][2];
#pragma unroll
        for (int bj = 0; bj < 2; ++bj)
#pragma unroll
            for (int n = 0; n < 2; ++n) gv[bj][n] = *(const f32x4*)(g1 + col0 + bj * HALF + n * 4) * descale;
#pragma unroll
        for (int ai = 0; ai < 2; ++ai) {
            f32x4 xv[4][2][2];
#pragma unroll
            for (int m = 0; m < 4; ++m) { const size_t off = (size_t)(row0 + ai * HALF + m * 16) * D + col0;
#pragma unroll
                for (int bj = 0; bj < 2; ++bj)
#pragma unroll
                    for (int n = 0; n < 2; ++n) xv[m][bj][n] = *(const f32x4*)(x + off + bj * HALF + n * 4); }
#pragma unroll
            for (int m = 0; m < 4; ++m) { const size_t off = (size_t)(row0 + ai * HALF + m * 16) * D + col0;
#pragma unroll
                for (int bj = 0; bj < 2; ++bj)
                    *(u32x4*)(Y + off + bj * HALF) = pack8(xv[m][bj][0] * DN_ALPHA + gv[bj][0] * acc[ai][bj][m][0], xv[m][bj][1] * DN_ALPHA + gv[bj][1] * acc[ai][bj][m][1]); }
            asm volatile("" ::: "memory");
        }
    }
};
struct EpiSwiglu {
    static constexpr bool PERM = true;
    const float* bgu; unsigned char* ACT; float descale, oscale;
    __device__ __forceinline__ void operator()(const f32x4 (&acc)[2][2][4][2], const Unit& u, int wr, int wc, int fr, int fq) const {
        const int row0 = u.pm * BM + wr * 64 + fr, col = u.pn * 128 + wc * 32 + 8 * fq;
        const float* bg = bgu + (size_t)u.e * (2 * DFF) + col;
        const f32x4 g0 = *(const f32x4*)bg, g1 = *(const f32x4*)(bg + 4), u0 = *(const f32x4*)(bg + DFF), u1 = *(const f32x4*)(bg + DFF + 4);
        const int colw = col & ~8, odd = fq & 1;
#pragma unroll
        for (int ai = 0; ai < 2; ++ai) {
            int w0[4], w1[4];
#pragma unroll
            for (int m = 0; m < 4; ++m) {
                f32x4 o[2];
#pragma unroll
                for (int n = 0; n < 2; ++n) {
                    const f32x4 gt = acc[ai][0][m][n] * descale + (n ? g1 : g0), up = acc[ai][1][m][n] * descale + (n ? u1 : u0);
#pragma unroll
                    for (int j = 0; j < 4; ++j) { const float g = fminf(gt[j], 7.0f), uu = fminf(fmaxf(up[j], -7.0f), 7.0f);
                        const float sg = __builtin_amdgcn_rcpf(1.0f + __builtin_amdgcn_exp2f(g * (-1.702f * 1.4426950408889634f)));
                        o[n][j] = (uu + 1.0f) * (g * sg) * oscale; }
                }
                w0[m] = __builtin_amdgcn_cvt_pk_fp8_f32(o[0][0], o[0][1], 0, false); w0[m] = __builtin_amdgcn_cvt_pk_fp8_f32(o[0][2], o[0][3], w0[m], true);
                w1[m] = __builtin_amdgcn_cvt_pk_fp8_f32(o[1][0], o[1][1], 0, false); w1[m] = __builtin_amdgcn_cvt_pk_fp8_f32(o[1][2], o[1][3], w1[m], true);
            }
#pragma unroll
            for (int p = 0; p < 2; ++p) { swap16(w0[2 * p], w0[2 * p + 1]); swap16(w1[2 * p], w1[2 * p + 1]);
                u32x4 w; w.x = (unsigned)w0[2 * p]; w.y = (unsigned)w1[2 * p]; w.z = (unsigned)w0[2 * p + 1]; w.w = (unsigned)w1[2 * p + 1];
                *(u32x4*)(ACT + (size_t)(row0 + ai * HALF + (2 * p + odd) * 16) * DFF + colw) = w; }
        }
    }
};
struct EpiDown {
    static constexpr bool PERM = true;
    const float* bd; unsigned char* YS; float descale, oscale;
    __device__ __forceinline__ void operator()(const f32x4 (&acc)[2][2][4][2], const Unit& u, int wr, int wc, int fr, int fq) const {
        const int row0 = u.pm * BM + wr * 64 + fr, col0 = u.pn * BM + wc * 32 + 8 * fq;
        const float* b = bd + (size_t)u.e * D + col0;
        f32x4 bv[2][2];
#pragma unroll
        for (int bj = 0; bj < 2; ++bj)
#pragma unroll
            for (int n = 0; n < 2; ++n) bv[bj][n] = *(const f32x4*)(b + bj * HALF + 4 * n) * oscale;
        const float ds = descale * oscale;
        const int colw = col0 & ~8, odd = fq & 1;
#pragma unroll
        for (int ai = 0; ai < 2; ++ai)
#pragma unroll
            for (int bj = 0; bj < 2; ++bj) {
                int w0[4], w1[4];
#pragma unroll
                for (int m = 0; m < 4; ++m) {
                    f32x4 o0 = acc[ai][bj][m][0] * ds + bv[bj][0], o1 = acc[ai][bj][m][1] * ds + bv[bj][1];
#pragma unroll
                    for (int j = 0; j < 4; ++j) { o0[j] = fminf(fmaxf(o0[j], -448.0f), 448.0f); o1[j] = fminf(fmaxf(o1[j], -448.0f), 448.0f); }
                    w0[m] = __builtin_amdgcn_cvt_pk_fp8_f32(o0[0], o0[1], 0, false); w0[m] = __builtin_amdgcn_cvt_pk_fp8_f32(o0[2], o0[3], w0[m], true);
                    w1[m] = __builtin_amdgcn_cvt_pk_fp8_f32(o1[0], o1[1], 0, false); w1[m] = __builtin_amdgcn_cvt_pk_fp8_f32(o1[2], o1[3], w1[m], true);
                }
#pragma unroll
                for (int p = 0; p < 2; ++p) { swap16(w0[2 * p], w0[2 * p + 1]); swap16(w1[2 * p], w1[2 * p + 1]);
                    u32x4 w; w.x = (unsigned)w0[2 * p]; w.y = (unsigned)w1[2 * p]; w.z = (unsigned)w0[2 * p + 1]; w.w = (unsigned)w1[2 * p + 1];
                    *(u32x4*)(YS + (size_t)(row0 + ai * HALF + (2 * p + odd) * 16) * D + colw + bj * HALF) = w; }
            }
    }
};

__device__ __forceinline__ void glds2(unsigned voff0, const void* sbase0, unsigned voff1, const void* sbase1, unsigned lds_dst) {
    unsigned keep; const unsigned lds_dst1 = lds_dst + 8192u;
    asm volatile("s_mov_b32 %0, m0\n\ts_mov_b32 m0, %5\n\ts_nop 0\n\tglobal_load_lds_dwordx4 %1, %2\n\ts_mov_b32 m0, %6\n\ts_nop 0\n\tglobal_load_lds_dwordx4 %3, %4\n\ts_mov_b32 m0, %0"
                 : "=&s"(keep) : "v"(voff0), "s"(sbase0), "v"(voff1), "s"(sbase1), "s"(lds_dst), "s"(lds_dst1) : "memory");
}
template <class Epi, bool GATHER, int MODE, bool SPLIT = false>
__device__ __forceinline__ void gemm_phase(PG8_LAS unsigned char* lds, const Gemm g, const Order& S, const Epi& E) {
    int tid_ = threadIdx.x; asm volatile("" : "+v"(tid_));
    const int tid = tid_, wid = __builtin_amdgcn_readfirstlane(tid >> 6), lane = tid & 63, wr = wid >> 2, wc = wid & 3, fr = lane & 15, fq = lane >> 4;
    const int RB = g.rowbytes, nt = RB / 128;
    int R0, C0; stage_rc(tid * 16, R0, C0);
    const int Rb0 = Epi::PERM ? ((R0 & ~31) + perm32(R0 & 31)) : R0;
    const unsigned voffB = (unsigned)(Rb0 * RB + C0 * 2), voffA = (unsigned)(R0 * RB + C0 * 2);
    const size_t kstep = (size_t)(BK * 2);
    const size_t qstep = (size_t)64 * RB;
    const size_t hstep = (size_t)HALF * RB;
    const size_t tstep = 2 * hstep;
    const unsigned ldsb = (unsigned)(size_t)lds + (unsigned)wid * 1024u;
    const int aoff = lds_byte(wr * 64 + fr, fq * 8), boff = lds_byte(wc * 32 + fr, fq * 8);
#define PG8_SA(b, h) (((b) * 2 + (h)) * HTB)
#define PG8_SB(b, h) ((4 + (b) * 2 + (h)) * HTB)
#define PG8_STAGEB(bufoff, gbase) glds2(voffB, (gbase), voffB, (gbase) + qstep, ldsb + (bufoff))
#define PG8_STAGEA(bufoff, rowb, v, h, kb) do { if constexpr (GATHER) glds2((v)[h][0], Ab + (kb), (v)[h][1], Ab + (kb), ldsb + (bufoff)); \
        else glds2(voffA, Ab + (rowb) + (h) * hstep + (kb), voffA, Ab + (rowb) + (h) * hstep + qstep + (kb), ldsb + (bufoff)); } while (0)
#define PG8_LDA(dst, b, h) do { _Pragma("unroll") for (int m = 0; m < 4; ++m) _Pragma("unroll") for (int k = 0; k < 2; ++k) dst[m][k] = *(const PG8_LAS bf16x8*)(lds + PG8_SA(b, h) + aoff + m * 2048 + k * 1024); } while (0)
#define PG8_LDB(dst, b, h) do { _Pragma("unroll") for (int n = 0; n < 2; ++n) _Pragma("unroll") for (int k = 0; k < 2; ++k) dst[n][k] = *(const PG8_LAS bf16x8*)(lds + PG8_SB(b, h) + boff + n * 2048 + k * 1024); } while (0)
#define PG8_MMA(ai, bj, At, Bt) do { __builtin_amdgcn_s_setprio(1); \
        if constexpr (MODE == 1) { _Pragma("unroll") for (int m = 0; m < 4; ++m) _Pragma("unroll") for (int n = 0; n < 2; ++n) { \
            const v8i_t b8 = __builtin_shufflevector(__builtin_bit_cast(v4i_t, Bt[n][0]), __builtin_bit_cast(v4i_t, Bt[n][1]), 0, 1, 2, 3, 4, 5, 6, 7); \
            const v8i_t a8 = __builtin_shufflevector(__builtin_bit_cast(v4i_t, At[m][0]), __builtin_bit_cast(v4i_t, At[m][1]), 0, 1, 2, 3, 4, 5, 6, 7); \
            asm volatile("v_mfma_f32_16x16x128_f8f6f4 %0, %1, %2, %0" : "+v"(acc[ai][bj][m][n]) : "v"(b8), "v"(a8)); } } \
        else if constexpr (MODE == 2) { _Pragma("unroll") for (int k = 0; k < 2; ++k) _Pragma("unroll") for (int m = 0; m < 4; ++m) _Pragma("unroll") for (int n = 0; n < 2; ++n) \
            asm volatile("v_mfma_i32_16x16x64_i8 %0, %1, %2, %0" : "+v"(acc[ai][bj][m][n]) : "v"(Bt[n][k]), "v"(At[m][k])); } \
        else { _Pragma("unroll") for (int m = 0; m < 4; ++m) _Pragma("unroll") for (int n = 0; n < 2; ++n) _Pragma("unroll") for (int k = 0; k < 2; ++k) \
            acc[ai][bj][m][n] = __builtin_amdgcn_mfma_f32_16x16x32_bf16(Bt[n][k], At[m][k], acc[ai][bj][m][n], 0, 0, 0); } \
        __builtin_amdgcn_s_setprio(0); } while (0)
#define PG8_WAIT_V(n) asm volatile("s_waitcnt vmcnt(" #n ")" ::: "memory")
#define PG8_WAIT_L(n) asm volatile("s_waitcnt lgkmcnt(" #n ")" ::: "memory")
#define PG8_BAR __builtin_amdgcn_s_barrier()
#define PG8_SCHED __builtin_amdgcn_sched_barrier(0)
#define PG8_VOFF(dst, U) do { if constexpr (GATHER) { _Pragma("unroll") for (int h = 0; h < 2; ++h) _Pragma("unroll") for (int i = 0; i < 2; ++i) { \
        const int row = g.rowidx[(U).pm * BM + h * HALF + i * 64 + R0]; dst[h][i] = (unsigned)row * (unsigned)RB + (unsigned)C0 * 2u; } } } while (0)
    Unit cur, nxt; int ui = 0;
    if (!S.next(0, cur)) return;
    f32x4 acc[2][2][4][2];
#pragma unroll
    for (int a = 0; a < 2; ++a)
#pragma unroll
        for (int b = 0; b < 2; ++b)
#pragma unroll
            for (int m = 0; m < 4; ++m)
#pragma unroll
                for (int n = 0; n < 2; ++n) acc[a][b][m][n] = (f32x4){0.f, 0.f, 0.f, 0.f};
    bf16x8 At[4][2], B0[2][2], B1[2][2];
    unsigned cv[2][2] = {{0u, 0u}, {0u, 0u}}, nv[2][2] = {{0u, 0u}, {0u, 0u}};
    PG8_VOFF(cv, cur);
    const char* const Ab = (const char*)g.A;
    size_t cAr = (size_t)cur.pm * tstep;
    const char* cB = (const char*)g.Bt + (size_t)cur.e * g.bstride + (size_t)cur.pn * tstep;
    PG8_STAGEB(PG8_SB(0, 0), cB); PG8_STAGEB(PG8_SB(0, 1), cB + hstep); PG8_STAGEA(PG8_SA(0, 0), cAr, cv, 0, 0); PG8_STAGEA(PG8_SA(0, 1), cAr, cv, 1, 0);
    if (wr == 1) PG8_BAR;
    PG8_WAIT_V(2); PG8_BAR;
    PG8_STAGEB(PG8_SB(1, 0), cB + kstep); PG8_STAGEA(PG8_SA(1, 0), cAr, cv, 0, kstep); PG8_STAGEB(PG8_SB(1, 1), cB + hstep + kstep);
    PG8_WAIT_V(6); PG8_BAR;
    for (;;) {
        float rs2[2] = {0.f, 0.f};
        if constexpr (MODE == 2) {
#pragma unroll
            for (int a = 0; a < 2; ++a) rs2[a] = g.rowscale[cur.pm * BM + a * HALF + wr * 64 + fq * 16 + fr]; }
        const bool has_next = S.next(ui + 1, nxt);
        const char* nB = has_next ? (const char*)g.Bt + (size_t)nxt.e * g.bstride + (size_t)nxt.pn * tstep : cB;
        const size_t nAr = has_next ? (size_t)nxt.pm * tstep : cAr;
        if (has_next) { PG8_VOFF(nv, nxt); }
        else {
#pragma unroll
            for (int h = 0; h < 2; ++h)
#pragma unroll
                for (int i = 0; i < 2; ++i) nv[h][i] = cv[h][i]; }
        for (int t = 0; t < nt - 2; t += 2) {
            if constexpr (SPLIT) if (t == g.split_t) {
                asm volatile("s_nop 15\n\ts_nop 15" ::: "memory");
#pragma unroll
                for (int a = 0; a < 2; ++a)
#pragma unroll
                    for (int m = 0; m < 4; ++m) { const float rr = g.splitratio[cur.pm * BM + a * HALF + wr * 64 + m * 16 + fr];
#pragma unroll
                        for (int b = 0; b < 2; ++b)
#pragma unroll
                            for (int n = 0; n < 2; ++n) { const v4i_t iv = __builtin_bit_cast(v4i_t, acc[a][b][m][n]);
                                const v4i_t ov = {(int)__builtin_rintf((float)iv[0] * rr), (int)__builtin_rintf((float)iv[1] * rr), (int)__builtin_rintf((float)iv[2] * rr), (int)__builtin_rintf((float)iv[3] * rr)};
                                acc[a][b][m][n] = __builtin_bit_cast(f32x4, ov); } }
                asm volatile("s_nop 7" ::: "memory");
            }
            const size_t k1 = (size_t)(t + 1) * kstep, k2 = k1 + kstep, k3 = k2 + kstep;
            const char* b2 = cB + k2; const char* b3 = cB + k3;
            PG8_LDB(B0, 0, 0); PG8_LDB(B1, 0, 1); PG8_SCHED; PG8_LDA(At, 0, 0); PG8_STAGEA(PG8_SA(1, 1), cAr, cv, 1, k1);
            PG8_WAIT_V(8); PG8_WAIT_L(0); PG8_BAR; PG8_MMA(0, 0, At, B0); PG8_MMA(0, 1, At, B1); PG8_BAR; PG8_SCHED;
            PG8_LDA(At, 0, 1); PG8_STAGEB(PG8_SB(0, 0), b2); PG8_STAGEB(PG8_SB(0, 1), b2 + hstep); PG8_STAGEA(PG8_SA(0, 0), cAr, cv, 0, k2);
            PG8_WAIT_V(8); PG8_WAIT_L(0); PG8_BAR; PG8_MMA(1, 0, At, B0); PG8_MMA(1, 1, At, B1); PG8_BAR; PG8_SCHED;
            PG8_LDB(B0, 1, 0); PG8_LDB(B1, 1, 1); PG8_SCHED; PG8_LDA(At, 1, 0); PG8_STAGEA(PG8_SA(0, 1), cAr, cv, 1, k2);
            PG8_WAIT_V(8); PG8_WAIT_L(0); PG8_BAR; PG8_MMA(0, 0, At, B0); PG8_MMA(0, 1, At, B1); PG8_BAR; PG8_SCHED;
            PG8_LDA(At, 1, 1); PG8_STAGEB(PG8_SB(1, 0), b3); PG8_STAGEB(PG8_SB(1, 1), b3 + hstep); PG8_STAGEA(PG8_SA(1, 0), cAr, cv, 0, k3);
            PG8_WAIT_V(8); PG8_WAIT_L(0); PG8_BAR; PG8_MMA(1, 0, At, B0); PG8_MMA(1, 1, At, B1); PG8_BAR; PG8_SCHED;
        }
        {
            const size_t k1 = (size_t)(nt - 1) * kstep;
            PG8_LDB(B0, 0, 0); PG8_LDB(B1, 0, 1); PG8_SCHED; PG8_LDA(At, 0, 0); PG8_STAGEA(PG8_SA(1, 1), cAr, cv, 1, k1);
            PG8_WAIT_V(8); PG8_WAIT_L(0); PG8_BAR; PG8_MMA(0, 0, At, B0); PG8_MMA(0, 1, At, B1); PG8_BAR; PG8_SCHED;
            PG8_LDA(At, 0, 1); PG8_STAGEB(PG8_SB(0, 0), nB); PG8_STAGEB(PG8_SB(0, 1), nB + hstep); PG8_STAGEA(PG8_SA(0, 0), nAr, nv, 0, 0);
            PG8_WAIT_V(8); PG8_WAIT_L(0); PG8_BAR; PG8_MMA(1, 0, At, B0); PG8_MMA(1, 1, At, B1); PG8_BAR; PG8_SCHED;
            PG8_LDB(B0, 1, 0); PG8_LDB(B1, 1, 1); PG8_SCHED; PG8_LDA(At, 1, 0); PG8_STAGEA(PG8_SA(0, 1), nAr, nv, 1, 0);
            PG8_WAIT_V(8); PG8_WAIT_L(0); PG8_BAR; PG8_MMA(0, 0, At, B0); PG8_MMA(0, 1, At, B1); PG8_BAR; PG8_SCHED;
            PG8_LDA(At, 1, 1); PG8_STAGEB(PG8_SB(1, 0), nB + kstep); PG8_STAGEB(PG8_SB(1, 1), nB + hstep + kstep); PG8_STAGEA(PG8_SA(1, 0), nAr, nv, 0, kstep);
            PG8_WAIT_V(8); PG8_WAIT_L(0); PG8_BAR; PG8_MMA(1, 0, At, B0); PG8_MMA(1, 1, At, B1); PG8_BAR; PG8_SCHED;
        }
        if (wr == 0) PG8_BAR;
        if constexpr (MODE != 0) asm volatile("s_nop 15\n\ts_nop 15" ::: "memory");
        if constexpr (MODE == 2) {
#pragma unroll
            for (int a = 0; a < 2; ++a)
#pragma unroll
                for (int m = 0; m < 4; ++m) { const float rs = __builtin_bit_cast(float, __builtin_amdgcn_ds_bpermute((m * 16 + fr) * 4, __builtin_bit_cast(int, rs2[a])));
#pragma unroll
                    for (int b = 0; b < 2; ++b)
#pragma unroll
                        for (int n = 0; n < 2; ++n) { const v4i_t iv = __builtin_bit_cast(v4i_t, acc[a][b][m][n]); acc[a][b][m][n] = (f32x4){(float)iv[0], (float)iv[1], (float)iv[2], (float)iv[3]} * rs; } }
        }
        E(acc, cur, wr, wc, fr, fq);
        if (!has_next) break;
#pragma unroll
        for (int a = 0; a < 2; ++a)
#pragma unroll
            for (int b = 0; b < 2; ++b)
#pragma unroll
                for (int m = 0; m < 4; ++m)
#pragma unroll
                    for (int n = 0; n < 2; ++n) acc[a][b][m][n] = (f32x4){0.f, 0.f, 0.f, 0.f};
        cur = nxt; cB = nB; cAr = nAr; ++ui;
#pragma unroll
        for (int h = 0; h < 2; ++h)
#pragma unroll
            for (int i = 0; i < 2; ++i) cv[h][i] = nv[h][i];
        if (wr == 1) PG8_BAR;
    }
    PG8_WAIT_V(0);
    PG8_BAR;
#undef PG8_SA
#undef PG8_SB
#undef PG8_STAGEA
#undef PG8_STAGEB
#undef PG8_LDA
#undef PG8_LDB
#undef PG8_MMA
#undef PG8_WAIT_V
#undef PG8_WAIT_L
#undef PG8_BAR
#undef PG8_SCHED
#undef PG8_VOFF
}
}

#ifndef WGM_IN
#define WGM_IN 8
#endif
#ifndef WGM_OUT
#define WGM_OUT 4
#endif
#ifndef WGM_GU
#define WGM_GU 4
#endif
#ifndef WGM_DN
#define WGM_DN 4
#endif
constexpr int NWAVES = 8;
constexpr int N_LAUNCHES = MK_N_LAUNCHES;
constexpr int PER_PHASE = 11;

constexpr size_t MiB = 1u << 20;
constexpr size_t WS_CTL = 0, CTL_ZERO_BYTES = 32768;
constexpr size_t WS_MOD = 1 * MiB;
constexpr size_t WS_ROPE = 2 * MiB;
constexpr size_t WS_TOPI = 10 * MiB;
constexpr size_t WS_GATE = WS_TOPI + 256 * 1024;
constexpr size_t WS_RANK = WS_GATE + 256 * 1024;
constexpr size_t WS_TSLOT = WS_RANK + 256 * 1024;
constexpr size_t WS_SLOTTOK = 11 * MiB;
constexpr size_t WS_WSP = 13 * MiB;
constexpr size_t WS_TILEE = 12 * MiB;
constexpr size_t WS_WIN = 16 * MiB;
constexpr size_t WS_WOUT = 38 * MiB;
constexpr size_t WS_H = 48 * MiB;
constexpr size_t WS_Q = 112 * MiB, WS_K = 160 * MiB, WS_V = 208 * MiB;
constexpr size_t WS_U = 256 * MiB, WS_VG = 272 * MiB;
constexpr size_t WS_CAT = 288 * MiB;
constexpr size_t WS_OPART = 352 * MiB;
constexpr size_t WS_LSE = 496 * MiB;
constexpr size_t WS_Y1 = 512 * MiB;
constexpr size_t WS_X1 = 576 * MiB;
constexpr size_t WS_WGU = 640 * MiB;
constexpr size_t WS_WD = 896 * MiB;
constexpr size_t WS_ACT = 1024 * MiB;
constexpr size_t WS_YS = 1168 * MiB;
constexpr size_t WS_H8 = 1456 * MiB;
constexpr size_t WS_RSH = 14 * MiB, WS_RSCAT = WS_RSH + 65536, WS_RSH2 = WS_RSCAT + 65536, WS_RSRATIO = WS_RSH2 + 65536, WS_RSSLOT = 15 * MiB;
constexpr size_t WS_GMO = 1488 * MiB;
constexpr size_t WS_HB = 1488 * MiB;
#ifndef BF_LO
#define BF_LO 22
#endif
#ifndef BF_HI
#define BF_HI 22
#endif
constexpr size_t WS_WINU = 1552 * MiB;
constexpr size_t WS_X8 = 1488 * MiB;
constexpr size_t WS_END = 1632 * MiB;
static_assert(WS_WINU + (size_t)(BF_HI - BF_LO) * 256 * D * 2 <= WS_END, "bf16 in-projection tiles");
constexpr float SC_H = 8.0f, SC_WGU = 127.0f / (4.5f * 0.022097087f), SC_ACT = 4.0f, SC_WD = 1024.0f, SC_WIN = 127.0f / (4.5f * 0.022097087f), SC_YS = 64.0f, SC_WOUT = 127.0f / (4.5f * 0.013148672f);
constexpr int CW_CNT = 1024, CW_CNT_STRIDE = 32;
constexpr int CW_BAR = 4096;
static_assert((CW_BAR + 3456) * 4 <= (int)CTL_ZERO_BYTES, "control words inside the per-call memset");

constexpr int RING_OFF = 0, RING_BYTES = 131072;
constexpr int LDSCTL_OFF = 143360, MISC_OFF = LDSCTL_OFF + 320;
constexpr int LDS_BYTES = 147456;

#define GAS __attribute__((address_space(1)))
#define LAS __attribute__((address_space(3)))
typedef unsigned short bf16;
typedef unsigned v4u __attribute__((ext_vector_type(4)));
typedef unsigned v2u __attribute__((ext_vector_type(2)));
typedef float f32x4 __attribute__((ext_vector_type(4)));
typedef GAS unsigned gu32;
#define RLX_AGENT __ATOMIC_RELAXED, __HIP_MEMORY_SCOPE_AGENT
#define LDS_WAIT() asm volatile("s_waitcnt lgkmcnt(0)" ::: "memory")
#define VM_WAIT() asm volatile("s_waitcnt vmcnt(0)" ::: "memory")
__device__ __forceinline__ unsigned f2bf(float f) { unsigned u = __builtin_bit_cast(unsigned, f); return (u + 0x7fffu + ((u >> 16) & 1u)) >> 16; }
__device__ __forceinline__ unsigned pk2(float lo, float hi) { return f2bf(lo) | (f2bf(hi) << 16); }
__device__ __forceinline__ float bf2f(unsigned short b) { return __builtin_bit_cast(float, ((unsigned)b) << 16); }
__device__ __forceinline__ float bflo(unsigned w) { return __builtin_bit_cast(float, w << 16); }
__device__ __forceinline__ float bfhi(unsigned w) { return __builtin_bit_cast(float, w & 0xffff0000u); }

#define XB_TMO      128
#define XB_XCNT(j)  (256  + 64 * (j))
#define XB_XSUB(j)  (1280 + 64 * (j))
#define XB_XGEN(j)  (2304 + 64 * (j))
#define XB_TOP      3328
#define XB_TOPGEN   3392
#define XCD_BAR_WORDS 3456
#define XB_SPIN_CAP (1u << 18)
__device__ __forceinline__ unsigned xb_ld(unsigned* p)              { return __hip_atomic_load(p, __ATOMIC_RELAXED, __HIP_MEMORY_SCOPE_AGENT); }
__device__ __forceinline__ unsigned xb_add(unsigned* p, unsigned v) { return __hip_atomic_fetch_add(p, v, __ATOMIC_RELAXED, __HIP_MEMORY_SCOPE_AGENT); }
__device__ __forceinline__ unsigned xb_xcc_id() { return (unsigned)__builtin_amdgcn_s_getreg((3 << 11) | 20) & 0xFu; }
#define XB_SPIN(cond, bar) do { unsigned _sp = 0; while (cond) { __builtin_amdgcn_s_sleep(1); \
    if ((++_sp & 255u) == 0u) { if (xb_ld(&(bar)[XB_TMO])) break; if (_sp > XB_SPIN_CAP) { atomicAdd(&(bar)[XB_TMO], 1u); break; } } } } while (0)
struct XcdBarrier { unsigned* bar; unsigned x; volatile LAS unsigned* st; };
__device__ __forceinline__ XcdBarrier xcd_barrier_post(unsigned* bar, volatile LAS unsigned* st) {
    XcdBarrier b; b.bar = bar; b.x = xb_xcc_id(); b.st = st;
    if (threadIdx.x == 0) (void)xb_add(&bar[XB_XCNT(b.x)], 1u);
    return b;
}
__device__ __forceinline__ void xcd_barrier_complete(unsigned* bar, unsigned x, unsigned& nloc, unsigned& nx) {
    const unsigned G = gridDim.x * gridDim.y * gridDim.z;
    unsigned sum, cnt, mine, sp = 0u;
    for (;;) {
        sum = 0u; cnt = 0u; mine = 0u;
#pragma unroll
        for (unsigned j = 0; j < 16; ++j) { const unsigned c = xb_ld(&bar[XB_XCNT(j)]); sum += c; cnt += (c > 0u) ? 1u : 0u; mine = (j == x) ? c : mine; }
        if (sum == G) break;
        __builtin_amdgcn_s_sleep(1);
        if ((++sp & 255u) == 0u) { if (xb_ld(&bar[XB_TMO])) break; if (sp > XB_SPIN_CAP) { atomicAdd(&bar[XB_TMO], 1u); break; } }
    }
    nloc = mine > 0u ? mine : 1u; nx = cnt > 0u ? cnt : 1u;
}
__device__ __forceinline__ void xcd_barrier(const XcdBarrier& b) {
    asm volatile("s_waitcnt vmcnt(0)" ::: "memory");
    __syncthreads();
    if (threadIdx.x == 0) {
        unsigned* bar = b.bar;
        __builtin_amdgcn_s_waitcnt(0);
        unsigned nloc = b.st[0], nx = b.st[1];
        if (nloc == 0u) { xcd_barrier_complete(bar, b.x, nloc, nx); b.st[0] = nloc; b.st[1] = nx; }
        const unsigned old = xb_add(&bar[XB_XSUB(b.x)], 1u);
        const unsigned gen = old / nloc;
        if (old + 1u == (gen + 1u) * nloc) {
            __builtin_amdgcn_fence(__ATOMIC_RELEASE, "agent");
            asm volatile("s_waitcnt vmcnt(0)" ::: "memory");
            const unsigned og = xb_add(&bar[XB_TOP], 1u);
            const unsigned tg = og / nx;
            if (og + 1u == (tg + 1u) * nx) xb_add(&bar[XB_TOPGEN], 1u);
            else XB_SPIN(xb_ld(&bar[XB_TOPGEN]) == tg, bar);
            __builtin_amdgcn_fence(__ATOMIC_ACQUIRE, "agent");
            xb_add(&bar[XB_XGEN(b.x)], 1u);
            asm volatile("s_waitcnt vmcnt(0)" ::: "memory");
        } else {
            XB_SPIN(xb_ld(&bar[XB_XGEN(b.x)]) == gen, bar);
            __builtin_amdgcn_fence(__ATOMIC_ACQUIRE, "agent");
            asm volatile("s_waitcnt vmcnt(0)" ::: "memory");
        }
    }
    __syncthreads();
}

struct Args {
    const float *x, *c; const int* pos; const float *ada_w, *ada_b, *w_in, *w_sp, *b_sp, *gln_g, *gln_b, *w_out, *ln1_g, *ln1_b, *rw, *rb, *wgu, *bgu, *wd, *bd, *ln2_g, *ln2_b;
    float* out; unsigned char* ws; int ph_lo, ph_hi;
};

struct Frame {
    LAS unsigned char* lds;
    volatile LAS unsigned* MISC;
    unsigned* ctl;
    int tid, lane, wave, vcu, G;
};

#define PHASE_IDS(F) do { int t_ = threadIdx.x; asm volatile("" : "+v"(t_)); (F).tid = t_; (F).lane = t_ & 63; } while (0)
template <int CTRL> __device__ __forceinline__ float dppf(float v) { return __builtin_bit_cast(float, __builtin_amdgcn_mov_dpp(__builtin_bit_cast(int, v), CTRL, 0xF, 0xF, true)); }
__device__ __forceinline__ float rdl(float v, int l) { return __builtin_bit_cast(float, __builtin_amdgcn_readlane(__builtin_bit_cast(int, v), l)); }
__device__ __forceinline__ float wave_sum(float v) {
    v += dppf<0xB1>(v); v += dppf<0x4E>(v); v += dppf<0x141>(v); v += dppf<0x140>(v);
    return (rdl(v, 0) + rdl(v, 16)) + (rdl(v, 32) + rdl(v, 48));
}
__device__ __forceinline__ int f8x4(float a, float b, float c, float d, float sc) {
    a = fminf(fmaxf(a * sc, -448.0f), 448.0f); b = fminf(fmaxf(b * sc, -448.0f), 448.0f); c = fminf(fmaxf(c * sc, -448.0f), 448.0f); d = fminf(fmaxf(d * sc, -448.0f), 448.0f);
    int w = __builtin_amdgcn_cvt_pk_fp8_f32(a, b, 0, false); return __builtin_amdgcn_cvt_pk_fp8_f32(c, d, w, true);
}
__device__ __forceinline__ unsigned f8x4u(float a, float b, float c, float d, float sc) {
    int w = __builtin_amdgcn_cvt_pk_fp8_f32(a * sc, b * sc, 0, false); return (unsigned)__builtin_amdgcn_cvt_pk_fp8_f32(c * sc, d * sc, w, true);
}
__device__ __forceinline__ unsigned q8x4(float a, float b, float c, float d, float sc) {
    const float M = 12582912.0f;
    const unsigned ua = __builtin_bit_cast(unsigned, __builtin_amdgcn_fmed3f(__builtin_fmaf(a, sc, M), M - 127.0f, M + 127.0f)), ub = __builtin_bit_cast(unsigned, __builtin_amdgcn_fmed3f(__builtin_fmaf(b, sc, M), M - 127.0f, M + 127.0f));
    const unsigned uc = __builtin_bit_cast(unsigned, __builtin_amdgcn_fmed3f(__builtin_fmaf(c, sc, M), M - 127.0f, M + 127.0f)), ud = __builtin_bit_cast(unsigned, __builtin_amdgcn_fmed3f(__builtin_fmaf(d, sc, M), M - 127.0f, M + 127.0f));
    return __builtin_amdgcn_perm(ub, ua, 0x0c0c0400u) | __builtin_amdgcn_perm(ud, uc, 0x04000c0cu);
}
__device__ __forceinline__ int dpp_x1(int v) { return __builtin_amdgcn_mov_dpp(v, 0xB1, 0xF, 0xF, true); }
__device__ __forceinline__ int dpp_x2(int v) { return __builtin_amdgcn_mov_dpp(v, 0x4E, 0xF, 0xF, true); }
__device__ __forceinline__ void quad_transpose(int (&v)[4], int p) {
    const bool lo2 = p < 2, ev = (p & 1) == 0;
#pragma unroll
    for (int i = 0; i < 2; ++i) { int t = lo2 ? v[i + 2] : v[i]; t = dpp_x2(t); if (lo2) v[i + 2] = t; else v[i] = t; }
#pragma unroll
    for (int i = 0; i < 4; i += 2) { int t = ev ? v[i + 1] : v[i]; t = dpp_x1(t); if (ev) v[i + 1] = t; else v[i] = t; }
}
__device__ __forceinline__ void store_row_b4(unsigned char* row, int lane, const unsigned (&w)[8]) {
    const int p = lane & 3; unsigned char* base = row + (lane >> 2) * 16;
#pragma unroll
    for (int g = 0; g < 2; ++g) { int v[4] = {(int)w[4 * g], (int)w[4 * g + 1], (int)w[4 * g + 2], (int)w[4 * g + 3]}; quad_transpose(v, p);
        v4u o; o.x = (unsigned)v[0]; o.y = (unsigned)v[1]; o.z = (unsigned)v[2]; o.w = (unsigned)v[3]; *(v4u*)(base + 256 * (4 * g + p)) = o; }
}
template <int NP, int STEP> __device__ __forceinline__ void store_row_b8(unsigned char* row, int lane, const v2u (&w)[NP]) {
    const int odd = lane & 1; unsigned char* base = row + (lane >> 1) * 16;
#pragma unroll
    for (int i = 0; i < NP / 2; ++i) { const v2u A = w[2 * i], B = w[2 * i + 1];
        const unsigned r0 = (unsigned)dpp_x1((int)(odd ? A.x : B.x)), r1 = (unsigned)dpp_x1((int)(odd ? A.y : B.y));
        v4u o; o.x = odd ? r0 : A.x; o.y = odd ? r1 : A.y; o.z = odd ? B.x : r0; o.w = odd ? B.y : r1;
        *(v4u*)(base + STEP * (2 * i + odd)) = o; }
}
__device__ __forceinline__ float wave_max(float v) {
    v = fmaxf(v, dppf<0xB1>(v)); v = fmaxf(v, dppf<0x4E>(v)); v = fmaxf(v, dppf<0x141>(v)); v = fmaxf(v, dppf<0x140>(v));
    return fmaxf(fmaxf(rdl(v, 0), rdl(v, 16)), fmaxf(rdl(v, 32), rdl(v, 48)));
}

__device__ __forceinline__ void p0_transpose_item(const float* W, int K, int N, bf16* WT, int k0, int n0, int drow0, LAS float* scr, int lane) {
#pragma unroll 8
    for (int i = 0; i < 32; ++i) { const int kk = 2 * i + (lane >> 5); scr[kk * 33 + (lane & 31)] = W[(size_t)(k0 + kk) * N + n0 + (lane & 31)]; }
    LDS_WAIT(); asm volatile("" ::: "memory");
    const int c = lane & 7;
#pragma unroll
    for (int j = 0; j < 4; ++j) { const int n = (lane >> 3) + 8 * j; const LAS float* s = scr + (8 * c) * 33 + n;
        v4u o; o.x = pk2(s[0 * 33], s[1 * 33]); o.y = pk2(s[2 * 33], s[3 * 33]); o.z = pk2(s[4 * 33], s[5 * 33]); o.w = pk2(s[6 * 33], s[7 * 33]);
        *(GAS v4u*)(WT + (size_t)(drow0 + n) * K + k0 + 8 * c) = o; }
    LDS_WAIT(); asm volatile("" ::: "memory");
}
#define FP8_ITEM_LOAD(rv, W, N, k0, n0) do { const float* wsrc_ = (W) + (size_t)((k0) + (lane >> 3)) * (N) + (n0) + 4 * (lane & 7); \
        _Pragma("unroll") for (int i_ = 0; i_ < 16; ++i_) rv[i_] = __builtin_nontemporal_load((const f32x4*)(wsrc_ + (size_t)(8 * i_) * (N))); } while (0)
#define W8_ITEM_STORE(PK, rv, K, WT, k0, drow0, scale) do { \
        LAS unsigned* sc_ = (LAS unsigned*)scr; \
        _Pragma("unroll") for (int i_ = 0; i_ < 16; ++i_) { const int k_ = 8 * i_ + (lane >> 3); sc_[8 * k_ + 4 * (i_ >> 1) + (lane & 7)] = PK(rv[i_][0], rv[i_][1], rv[i_][2], rv[i_][3], (scale)); } \
        LDS_WAIT(); asm volatile("" ::: "memory"); \
        const int kg_ = lane >> 3, c_ = lane & 7; unsigned t_[16]; \
        _Pragma("unroll") for (int i_ = 0; i_ < 16; ++i_) t_[i_] = sc_[8 * (16 * kg_ + i_) + 4 * kg_ + c_]; \
        LDS_WAIT(); asm volatile("" ::: "memory"); \
        unsigned u_[4][4]; \
        _Pragma("unroll") for (int q_ = 0; q_ < 4; ++q_) { const unsigned a_ = t_[4 * q_], b_ = t_[4 * q_ + 1], cc_ = t_[4 * q_ + 2], d_ = t_[4 * q_ + 3]; \
            const unsigned abl_ = __builtin_amdgcn_perm(b_, a_, 0x05010400u), abh_ = __builtin_amdgcn_perm(b_, a_, 0x07030602u), cdl_ = __builtin_amdgcn_perm(d_, cc_, 0x05010400u), cdh_ = __builtin_amdgcn_perm(d_, cc_, 0x07030602u); \
            u_[0][q_] = __builtin_amdgcn_perm(cdl_, abl_, 0x05040100u); u_[1][q_] = __builtin_amdgcn_perm(cdl_, abl_, 0x07060302u); \
            u_[2][q_] = __builtin_amdgcn_perm(cdh_, abh_, 0x05040100u); u_[3][q_] = __builtin_amdgcn_perm(cdh_, abh_, 0x07060302u); } \
        _Pragma("unroll") for (int j_ = 0; j_ < 4; ++j_) { v4u o_; o_.x = u_[j_][0]; o_.y = u_[j_][1]; o_.z = u_[j_][2]; o_.w = u_[j_][3]; \
            __builtin_nontemporal_store(o_, (GAS v4u*)((WT) + (size_t)((drow0) + 4 * c_ + j_) * (K) + (k0) + 16 * kg_)); } \
        } while (0)
#define FP8_ITEM_STORE(rv, K, WT, k0, drow0, scale) W8_ITEM_STORE(f8x4u, rv, K, WT, k0, drow0, scale)

#define I8_ITEM_STORE(rv, K, WT, k0, drow0, scale) W8_ITEM_STORE(q8x4, rv, K, WT, k0, drow0, scale)
__device__ __forceinline__ int map_win(int ca) {
    if (ca >= 2 * AW) return ca;
    const int pn = ca >> 8, w = ca & 255, hh = w >> 7, i = w & 127;
    return (pn << 8) + ((i >> 6) << 7) + (hh << 6) + (i & 63);
}
__device__ __forceinline__ int map_wgu(int ca) {
    return ca < DFF ? ((ca >> 7) << 8) + (ca & 127) : (((ca - DFF) >> 7) << 8) + 128 + (ca & 127);
}

__device__ __forceinline__ void phase0(Frame& F, const Args& a) {
    PHASE_IDS(F);
    unsigned char* ws = a.ws;
    if (blockIdx.x < (6 * D) / 64) {
        LAS float* sl = (LAS float*)(F.lds);
        LAS float* red = (LAS float*)(F.lds + 32768);
        for (int i = F.tid; i < BATCH * D; i += NWAVES * 64) { const float v = a.c[i]; sl[i] = v / (1.0f + __expf(-v)); }
        __syncthreads();
        const int j = blockIdx.x * 64 + F.lane, k0 = F.wave * 256;
        float s0 = 0.f, s1 = 0.f, s2 = 0.f, s3 = 0.f;
        for (int kb = 0; kb < 256; kb += 64) {
            float wv[64];
#pragma unroll
            for (int k = 0; k < 64; ++k) wv[k] = __builtin_nontemporal_load(a.ada_w + (size_t)(k0 + kb + k) * (6 * D) + j);
#pragma unroll
            for (int k = 0; k < 64; ++k) { const float w = wv[k]; const int kk = k0 + kb + k;
                s0 += sl[kk] * w; s1 += sl[D + kk] * w; s2 += sl[2 * D + kk] * w; s3 += sl[3 * D + kk] * w; } }
        red[(F.wave * 4 + 0) * 64 + F.lane] = s0; red[(F.wave * 4 + 1) * 64 + F.lane] = s1; red[(F.wave * 4 + 2) * 64 + F.lane] = s2; red[(F.wave * 4 + 3) * 64 + F.lane] = s3;
        __syncthreads();
        if (F.tid < 256) { const int b = F.tid >> 6, l = F.tid & 63; float s = a.ada_b[blockIdx.x * 64 + l];
#pragma unroll
            for (int w = 0; w < 8; ++w) s += red[(w * 4 + b) * 64 + l];
            ((float*)(ws + WS_MOD))[(size_t)b * (6 * D) + blockIdx.x * 64 + l] = s; }
        __syncthreads();
    }
    if (blockIdx.x == F.G - 1) {
        for (int i = F.tid; i < 4 * 128 * 128 / 2; i += NWAVES * 64) { const int e0 = 2 * i, t = (e0 >> 7) & 127, s0 = e0 & 127; const float2 w = *(const float2*)(a.w_sp + e0);
            ((unsigned*)(ws + WS_WSP))[i] = pk2(s0 <= t ? w.x : 0.f, s0 + 1 <= t ? w.y : 0.f); }
    }
    const int gw = F.vcu * NWAVES + F.wave, NGW = F.G * NWAVES;
    for (int m = gw; m < T; m += NGW) {
        const float p = (float)a.pos[m];
        const float inv = exp2f(-(float)F.lane * (13.287712379549449f / 64.0f));
        float sn, cs; sincosf(p * inv, &sn, &cs);
        typedef _Float16 h16x2 __attribute__((ext_vector_type(2)));
        ((h16x2*)(ws + WS_ROPE))[(size_t)m * 64 + F.lane] = (h16x2){(_Float16)cs, (_Float16)sn};
    }
    LAS float* scr = (LAS float*)(F.lds + RING_OFF + F.wave * 16896);
    constexpr int I_IN = (D / 128) * (NPROJ / 32), I_OUT = (D / 128) * (D / 32), I_GU = (D / 128) * (2 * DFF / 32), I_D = (DFF / 128) * (D / 32);
    constexpr int I_U = (D / 64) * ((BF_HI - BF_LO) * 256 / 32);
    constexpr int NITEMS = I_IN + I_OUT + I_U;
    for (int it = gw; it < NITEMS; it += NGW) {
        int r = it;
        if (r < I_IN) { const int nb = NPROJ / 32, k0 = 128 * (r / nb), n0 = 32 * (r % nb), lane = F.lane; f32x4 rv[16]; LAS float* scr8 = (LAS float*)(F.lds + RING_OFF + F.wave * 16896);
            FP8_ITEM_LOAD(rv, a.w_in, NPROJ, k0, n0); { LAS float* scr = scr8; I8_ITEM_STORE(rv, D, ws + WS_WIN, k0, map_win(n0), SC_WIN); } continue; } r -= I_IN;
        if (r < I_OUT) { const int nb = D / 32, k0 = 128 * (r / nb), n0 = 32 * (r % nb), lane = F.lane; f32x4 rv[16]; LAS float* scr8 = (LAS float*)(F.lds + RING_OFF + F.wave * 16896);
            FP8_ITEM_LOAD(rv, a.w_out, D, k0, n0); { LAS float* scr = scr8; I8_ITEM_STORE(rv, D, ws + WS_WOUT, k0, n0, SC_WOUT); } continue; } r -= I_OUT;
        { const int nb = (BF_HI - BF_LO) * 256 / 32, k0 = 64 * (r / nb), n0 = BF_LO * 256 + 32 * (r % nb); p0_transpose_item(a.w_in, D, NPROJ, (bf16*)(ws + WS_WINU), k0, n0, map_win(n0) - BF_LO * 256, scr, F.lane); }
        (void)I_GU; (void)I_D;
    }
}
constexpr int CONV_I_GU = NE * (D / 128) * (2 * DFF / 32), CONV_I_D = NE * (DFF / 128) * (D / 32), CONV_ITEMS = CONV_I_GU + CONV_I_D;
constexpr int CONV_PER_WAVE = 2, CONV_CHUNK = 8 * CONV_PER_WAVE, CONV_NCHUNK = CONV_ITEMS / CONV_CHUNK;
constexpr int CW_CONV = 128;
struct ConvItem { const float* W; unsigned char* WT; int KK, NN, k0, n0, d0; float scale; bool i8; };
__device__ __forceinline__ ConvItem conv_decode(const Args& a, int r) {
    ConvItem c;
    if (r < CONV_I_GU) { constexpr int PER = (D / 128) * (2 * DFF / 32), NB = 2 * DFF / 32; const int e = r / PER, q = r % PER; c.KK = D; c.NN = 2 * DFF; c.k0 = 128 * (q / NB); c.n0 = 32 * (q % NB); c.d0 = map_wgu(c.n0);
        c.W = a.wgu + (size_t)e * D * 2 * DFF; c.WT = a.ws + WS_WGU + (size_t)e * 2 * DFF * D; c.scale = SC_WGU; c.i8 = true; }
    else { r -= CONV_I_GU; constexpr int PER = (DFF / 128) * (D / 32), NB = D / 32; const int e = r / PER, q = r % PER; c.KK = DFF; c.NN = D; c.k0 = 128 * (q / NB); c.n0 = 32 * (q % NB); c.d0 = c.n0;
        c.W = a.wd + (size_t)e * DFF * D; c.WT = a.ws + WS_WD + (size_t)e * D * DFF; c.scale = SC_WD; c.i8 = false; }
    return c;
}
__device__ __forceinline__ void conv_dyn(Frame& F, const Args& a, int limit) {
    PHASE_IDS(F);
    const int lane = F.lane;
    LAS float* scr = (LAS float*)(F.lds + RING_OFF + F.wave * 16896);
    volatile LAS int* slot = (volatile LAS int*)(F.lds + 8 * 16896);
    __syncthreads();
    if (F.tid == 0) { const int c0 = (int)__hip_atomic_fetch_add(F.ctl + CW_CONV, 1u, RLX_AGENT); slot[0] = c0;
        slot[1] = (c0 < limit) ? (int)__hip_atomic_fetch_add(F.ctl + CW_CONV, 1u, RLX_AGENT) : CONV_NCHUNK; }
    __syncthreads();
    int id = slot[0], nid = slot[1], par = 0;
    f32x4 ra[16], rb[16];
    if (id < CONV_NCHUNK) {
        const int r0 = id * CONV_CHUNK + F.wave * 2;
        { const ConvItem c = conv_decode(a, r0); FP8_ITEM_LOAD(ra, c.W, c.NN, c.k0, c.n0); }
        { const ConvItem c = conv_decode(a, r0 + 1); FP8_ITEM_LOAD(rb, c.W, c.NN, c.k0, c.n0); }
    }
    while (id < CONV_NCHUNK) {
        int claim = CONV_NCHUNK;
        if (F.tid == 0 && nid < limit) claim = (int)__hip_atomic_fetch_add(F.ctl + CW_CONV, 1u, RLX_AGENT);
        const int r0 = id * CONV_CHUNK + F.wave * 2, n0 = nid * CONV_CHUNK + F.wave * 2;
        { const ConvItem c = conv_decode(a, r0); if (c.i8) I8_ITEM_STORE(ra, c.KK, c.WT, c.k0, c.d0, c.scale); else FP8_ITEM_STORE(ra, c.KK, c.WT, c.k0, c.d0, c.scale); }
        if (nid < CONV_NCHUNK) { const ConvItem c = conv_decode(a, n0); FP8_ITEM_LOAD(ra, c.W, c.NN, c.k0, c.n0); }
        { const ConvItem c = conv_decode(a, r0 + 1); if (c.i8) I8_ITEM_STORE(rb, c.KK, c.WT, c.k0, c.d0, c.scale); else FP8_ITEM_STORE(rb, c.KK, c.WT, c.k0, c.d0, c.scale); }
        if (nid < CONV_NCHUNK) { const ConvItem c = conv_decode(a, n0 + 1); FP8_ITEM_LOAD(rb, c.W, c.NN, c.k0, c.n0); }
        if (F.tid == 0) slot[2 + par] = claim;
        asm volatile("s_waitcnt lgkmcnt(0)\n\ts_barrier" ::: "memory");
        id = nid; nid = slot[2 + par]; par ^= 1;
    }
    __syncthreads();
}

__device__ __forceinline__ void phase1(Frame& F, const Args& a) {
    PHASE_IDS(F);
    const int gw = F.vcu * NWAVES + F.wave, NGW = F.G * NWAVES;
    const float* mod = (const float*)(a.ws + WS_MOD);
    bf16* H = (bf16*)(a.ws + WS_H);
    f32x4 vn[8];
    if (gw < T) {
#pragma unroll
        for (int j = 0; j < 8; ++j) vn[j] = __builtin_nontemporal_load((const f32x4*)(a.x + (size_t)gw * D) + F.lane + 64 * j);
    }
    for (int m = gw; m < T; m += NGW) {
        f32x4 v[8]; float s = 0.f;
#pragma unroll
        for (int j = 0; j < 8; ++j) { v[j] = vn[j]; s += (v[j].x + v[j].y) + (v[j].z + v[j].w); }
        if (m + NGW < T) {
#pragma unroll
            for (int j = 0; j < 8; ++j) vn[j] = __builtin_nontemporal_load((const f32x4*)(a.x + (size_t)(m + NGW) * D) + F.lane + 64 * j);
        }
        const float mean = wave_sum(s) * (1.f / D); float s2 = 0.f;
#pragma unroll
        for (int j = 0; j < 8; ++j) { v[j] = v[j] - mean; s2 += (v[j].x * v[j].x + v[j].y * v[j].y) + (v[j].z * v[j].z + v[j].w * v[j].w); }
        const float rstd = 1.f / sqrtf(wave_sum(s2) * (1.f / D) + LN_EPS);
        const float* mb = mod + (size_t)(m / SEQ) * (6 * D);
        unsigned* o4 = (unsigned*)((unsigned char*)H + (size_t)m * D) + F.lane; float am = 0.f;
#pragma unroll
        for (int j = 0; j < 8; ++j) { const f32x4 sh = *((const f32x4*)mb + F.lane + 64 * j), sc = *((const f32x4*)(mb + D) + F.lane + 64 * j);
            v[j] = v[j] * rstd * (sc + 1.0f) + sh; am = fmaxf(fmaxf(am, fmaxf(fabsf(v[j].x), fabsf(v[j].y))), fmaxf(fabsf(v[j].z), fabsf(v[j].w))); }
        am = fmaxf(wave_max(am), 1e-20f);
        const float qs = 127.0f / am;
#pragma unroll
        for (int j = 0; j < 8; ++j) o4[64 * j] = q8x4(v[j].x, v[j].y, v[j].z, v[j].w, qs);
        if (F.lane == 0) ((float*)(a.ws + WS_RSH))[m] = am * (1.0f / 127.0f);
    }
}

__device__ __forceinline__ void phase3_attn_naive(Frame& F, const Args& a) {
    const int gw = F.vcu * NWAVES + F.wave, NGW = F.G * NWAVES;
    const bf16* Q = (const bf16*)(a.ws + WS_Q); const bf16* Kb = (const bf16*)(a.ws + WS_K); const bf16* Vb = (const bf16*)(a.ws + WS_V);
    bf16* CAT = (bf16*)(a.ws + WS_CAT);
    for (int it = gw; it < T * NH; it += NGW) {
        const int m = it / NH, h = it % NH, b = m / SEQ, t = m % SEQ;
        const unsigned qw = *((const unsigned*)(Q + (size_t)m * AW + h * HD) + F.lane);
        const float q0 = bflo(qw), q1 = bfhi(qw);
        float mx = -1e30f, l = 0.f, o0 = 0.f, o1 = 0.f;
        for (int c0 = 0; c0 < 3 * 129; c0 += 4) {
            float sc[4]; unsigned vw[4];
#pragma unroll
            for (int u = 0; u < 4; ++u) {
                const int c = c0 + u, br = c / 129, j = c - br * 129, dil = 1 << (2 * br), p = t - dil * j;
                const bool ok = (c < 3 * 129) && (p >= 0);
                const size_t row = (size_t)(b * SEQ + (ok ? p : t));
                const unsigned kw = *((const unsigned*)(Kb + row * AW + h * HD) + F.lane);
                vw[u] = *((const unsigned*)(Vb + row * AW + h * HD) + F.lane);
                const float d = wave_sum(q0 * bflo(kw) + q1 * bfhi(kw));
                sc[u] = ok ? d : -1e30f;
            }
            const float cm = fmaxf(fmaxf(sc[0], sc[1]), fmaxf(sc[2], sc[3])), nm = fmaxf(mx, cm), r = __expf(mx - nm);
            l *= r; o0 *= r; o1 *= r; mx = nm;
#pragma unroll
            for (int u = 0; u < 4; ++u) { const float pp = sc[u] > -1e29f ? __expf(sc[u] - nm) : 0.f; l += pp; o0 += pp * bflo(vw[u]); o1 += pp * bfhi(vw[u]); }
        }
        const float il = 1.0f / l;
        *((unsigned*)(CAT + (size_t)m * D + h * HD) + F.lane) = pk2(o0 * il, o1 * il);
    }
}
__device__ __forceinline__ int pi16(int k) { return (k & ~12) | ((k & 4) << 1) | ((k & 8) >> 1); }
__device__ __forceinline__ int fswz(int R) { return ((R & 3) << 2) | ((R >> 2) & 3); }
__device__ __forceinline__ void phase3_gmlp(Frame& F, const Args& a) {
    PHASE_IDS(F);
    typedef short s16x4 __attribute__((ext_vector_type(4)));
    typedef short bf16x8_t __attribute__((ext_vector_type(8)));
    typedef __attribute__((__vector_size__(4 * sizeof(short)))) short v4i16_t;
    const bf16* U = (const bf16*)(a.ws + WS_U); const bf16* VG = (const bf16*)(a.ws + WS_VG); bf16* GMO = (bf16*)(a.ws + WS_GMO); const bf16* WSP = (const bf16*)(a.ws + WS_WSP);
    constexpr int NUNITS = BATCH * (SEQ / 128) * 2;
    const int lane = F.lane, wid = F.wave, fr = lane & 15, fq = lane >> 4;
    for (int un = F.vcu; un < NUNITS; un += F.G) {
        const int gp = un & 1, ch = un >> 1;
        __syncthreads();
        v4u wrow[16];
#pragma unroll
        for (int rr = 0; rr < 16; ++rr) wrow[rr] = *((const v4u*)(VG + ((size_t)ch * 128 + wid * 16 + rr) * GW) + lane);
        const f32x4 lg0 = *((const f32x4*)a.gln_g + 2 * lane), lg1 = *((const f32x4*)a.gln_g + 2 * lane + 1), lb0 = *((const f32x4*)a.gln_b + 2 * lane), lb1 = *((const f32x4*)a.gln_b + 2 * lane + 1);
        const int nks = (16 * wid + 15) / 32 + 1;
        bf16x8_t wf[2][4];
#pragma unroll
        for (int g2 = 0; g2 < 2; ++g2)
#pragma unroll
            for (int ks = 0; ks < 4; ++ks) wf[g2][ks] = (ks < nks) ? *(const bf16x8_t*)(WSP + ((size_t)(2 * gp + g2) * 128 + 16 * wid + fr) * 128 + 32 * ks + 8 * fq) : (bf16x8_t){0, 0, 0, 0, 0, 0, 0, 0};
#pragma unroll
        for (int rr = 0; rr < 16; ++rr) {
            const int s_ = wid * 16 + rr;
            const v4u w = wrow[rr];
            float v[8] = {bflo(w.x), bfhi(w.x), bflo(w.y), bfhi(w.y), bflo(w.z), bfhi(w.z), bflo(w.w), bfhi(w.w)};
            float sm = 0.f;
#pragma unroll
            for (int i = 0; i < 8; ++i) sm += v[i];
            const float mean = wave_sum(sm) * (1.f / GW); float s2 = 0.f;
#pragma unroll
            for (int i = 0; i < 8; ++i) { v[i] -= mean; s2 += v[i] * v[i]; }
            const float rstd = 1.f / sqrtf(wave_sum(s2) * (1.f / GW) + LN_EPS);
            if ((lane >> 5) == gp) {
                v4u o; o.x = pk2(v[0] * rstd * lg0.x + lb0.x, v[1] * rstd * lg0.y + lb0.y); o.y = pk2(v[2] * rstd * lg0.z + lb0.z, v[3] * rstd * lg0.w + lb0.w);
                o.z = pk2(v[4] * rstd * lg1.x + lb1.x, v[5] * rstd * lg1.y + lb1.y); o.w = pk2(v[6] * rstd * lg1.z + lb1.z, v[7] * rstd * lg1.w + lb1.w);
                *(LAS v4u*)(F.lds + ((lane >> 4) & 1) * 32768 + s_ * 256 + (((lane & 15) ^ fswz(s_)) << 4)) = o;
            }
        }
        LDS_WAIT();
        __syncthreads();
        const int q4 = (lane >> 2) & 3, p4 = lane & 3;
        const int t = 16 * wid + fr; const size_t row = (size_t)ch * 128 + t;
#pragma unroll
        for (int g2 = 0; g2 < 2; ++g2) {
            const int g = 2 * gp + g2;
            f32x4 acc[8];
#pragma unroll
            for (int ct = 0; ct < 8; ++ct) acc[ct] = (f32x4){0.f, 0.f, 0.f, 0.f};
#pragma unroll
            for (int ks = 0; ks < 4; ++ks) {
                if (ks < nks) {
                    const int r1 = 32 * ks + 8 * fq + q4, r2 = r1 + 4, f1 = fswz(r1), f2 = fswz(r2);
#pragma unroll
                    for (int ct = 0; ct < 8; ++ct) {
                        const int cc = 2 * ct + (p4 >> 1);
                        const s16x4 lo = __builtin_bit_cast(s16x4, __builtin_amdgcn_ds_read_tr16_b64_v4i16((LAS v4i16_t*)(F.lds + g2 * 32768 + r1 * 256 + ((cc ^ f1) << 4) + 8 * (p4 & 1))));
                        const s16x4 hi = __builtin_bit_cast(s16x4, __builtin_amdgcn_ds_read_tr16_b64_v4i16((LAS v4i16_t*)(F.lds + g2 * 32768 + r2 * 256 + ((cc ^ f2) << 4) + 8 * (p4 & 1))));
                        const bf16x8_t vf = __builtin_shufflevector(lo, hi, 0, 1, 2, 3, 4, 5, 6, 7);
                        acc[ct] = __builtin_amdgcn_mfma_f32_16x16x32_bf16(vf, wf[g2][ks], acc[ct], 0, 0, 0);
                    }
                }
            }
            const float bias = a.b_sp[g * 128 + t];
#pragma unroll
            for (int ct = 0; ct < 8; ++ct) {
                const int c = 16 * ct + 4 * fq;
                const v2u uw = *(const v2u*)(U + row * GW + g * 128 + c);
                v2u o; o.x = pk2(bflo(uw.x) * (acc[ct][0] + bias), bfhi(uw.x) * (acc[ct][1] + bias)); o.y = pk2(bflo(uw.y) * (acc[ct][2] + bias), bfhi(uw.y) * (acc[ct][3] + bias));
                *(v2u*)(GMO + row * GW + g * 128 + c) = o;
            }
        }
    }
    __syncthreads();
}

typedef short s16x4 __attribute__((ext_vector_type(4)));
typedef short bf16x8_t __attribute__((ext_vector_type(8)));
typedef __attribute__((__vector_size__(4 * sizeof(short)))) short v4i16_t;
constexpr int ATT_K_OFF = 0, ATT_V_OFF = 65536;
constexpr int ATT_UNITS = BATCH * NH * 96;
struct AttU { int b, h, br, dsh, rho, n; };
__device__ __forceinline__ AttU att_decode(int xq, int jq, int ri) {
    AttU c; const int t3 = ri / 3, bh = xq + 8 * t3; c.br = ri - 3 * t3; c.b = bh / NH; c.h = bh - c.b * NH;
    c.dsh = 2 * c.br; const int nbsh = 5 - c.dsh; c.rho = jq >> nbsh; c.n = jq & ((1 << nbsh) - 1); return c;
}
__device__ __forceinline__ void glds1(unsigned voff, const void* sbase, unsigned lds_dst) {
    unsigned keep;
    asm volatile("s_mov_b32 %0, m0\n\ts_mov_b32 m0, %3\n\ts_nop 0\n\tglobal_load_lds_dwordx4 %1, %2\n\ts_mov_b32 m0, %0" : "=&s"(keep) : "v"(voff), "s"(sbase), "s"(lds_dst) : "memory");
}
__device__ __forceinline__ void att_issue(Frame& F, const bf16* T_, const AttU& c, unsigned lrow3k, unsigned chunk, int tile_off, int wid) {
    const char* base = (const char*)(T_ + (size_t)c.b * SEQ * AW + c.h * HD) + (size_t)c.rho * (AW * 2);
    const unsigned ldsb = (unsigned)(size_t)(F.lds + tile_off) + (unsigned)wid * 1024u;
    const unsigned voff = (lrow3k << c.dsh) + chunk;
    const int kap0 = 128 * (c.n - 1);
#pragma unroll
    for (int r = 0; r < 8; ++r) { const int kb = kap0 + 32 * r + ((c.n == 0 && r < 4) ? 128 : 0);
        glds1(voff, base + ((size_t)kb << c.dsh) * (AW * 2), ldsb + r * 8192); }
}
__device__ __forceinline__ void att_load_q(bf16x8_t (&q)[4], const void* p) {
    asm volatile("global_load_dwordx4 %0, %4, off\n\tglobal_load_dwordx4 %1, %4, off offset:64\n\tglobal_load_dwordx4 %2, %4, off offset:128\n\tglobal_load_dwordx4 %3, %4, off offset:192"
                 : "=&v"(q[0]), "=&v"(q[1]), "=&v"(q[2]), "=&v"(q[3]) : "v"(p) : "memory");
}
#define ATT_BAR() do { asm volatile("" ::: "memory"); __builtin_amdgcn_s_barrier(); asm volatile("" ::: "memory"); } while (0)
__device__ __forceinline__ void phase3_attn(Frame& F, const Args& a) {
    PHASE_IDS(F);
    const bf16* Q = (const bf16*)(a.ws + WS_Q); const bf16* Kb = (const bf16*)(a.ws + WS_K); const bf16* Vb = (const bf16*)(a.ws + WS_V);
    bf16* OP = (bf16*)(a.ws + WS_OPART); float* LSE = (float*)(a.ws + WS_LSE);
    const int lane = F.lane, wid = F.wave, fr = lane & 15, fq = lane >> 4;
    if (F.G != 256) return;
    const int xq = F.vcu >> 5, jq = F.vcu & 31;
    const int lrow = wid * 4 + fq;
    const unsigned k3k = (unsigned)lrow * (AW * 2), kch = (unsigned)((fr ^ (lrow & 15)) << 4);
    const unsigned v3k = (unsigned)((lrow & 16) | pi16(lrow & 15)) * (AW * 2), vch = (unsigned)((fr ^ fswz(lrow)) << 4);
    const int qi = 16 * wid + fr, kt0 = wid & ~1;
    __syncthreads();
    int ri = 0;
    AttU cu = att_decode(xq, jq, 0);
    bf16x8_t qf[4], qn[4];
    int tq = ((128 * cu.n + qi) << cu.dsh) + cu.rho;
    att_issue(F, Kb, cu, k3k, kch, ATT_K_OFF, wid);
    att_load_q(qn, (const bf16x8_t*)(Q + ((size_t)(cu.b * SEQ + tq) * AW + cu.h * HD)) + fq);
    att_issue(F, Vb, cu, v3k, vch, ATT_V_OFF, wid);
    for (;;) {
        const bool first = (ri == 0), lastu = (ri == 17);
        const AttU cn = att_decode(xq, jq, lastu ? ri : ri + 1);
        if (first) asm volatile("s_waitcnt vmcnt(8)" : "+v"(qn[0]), "+v"(qn[1]), "+v"(qn[2]), "+v"(qn[3]) :: "memory");
        else asm volatile("s_waitcnt vmcnt(13)" : "+v"(qn[0]), "+v"(qn[1]), "+v"(qn[2]), "+v"(qn[3]) :: "memory");
#pragma unroll
        for (int s = 0; s < 4; ++s) qf[s] = qn[s];
        ATT_BAR();
        f32x4 st[10];
#pragma unroll
        for (int i = 0; i < 10; ++i) {
            st[i] = (f32x4){0.f, 0.f, 0.f, 0.f};
#pragma unroll
            for (int s = 0; s < 4; ++s) {
                const bf16x8_t kf = *(const LAS bf16x8_t*)(F.lds + ATT_K_OFF + ((kt0 + i) * 16 + fr) * 256 + (((4 * s + fq) ^ fr) << 4));
                st[i] = __builtin_amdgcn_mfma_f32_16x16x32_bf16(kf, qf[s], st[i], 0, 0, 0);
            }
        }
        asm volatile("s_waitcnt lgkmcnt(0)" ::: "memory");
        ATT_BAR();
        att_issue(F, Kb, cn, k3k, kch, ATT_K_OFF, wid);
        const int tqn = ((128 * cn.n + qi) << cn.dsh) + cn.rho;
        att_load_q(qn, (const bf16x8_t*)(Q + ((size_t)(cn.b * SEQ + tqn) * AW + cn.h * HD)) + fq);
        const int klo = (cu.n > 0) ? qi : (qi > 128 ? qi : 128), khi = qi + 128;
        const int kk0 = 16 * kt0 + 4 * fq;
#pragma unroll
        for (int i = 0; i < 2; ++i)
#pragma unroll
            for (int r = 0; r < 4; ++r) st[i][r] = (kk0 + 16 * i + r >= klo) ? st[i][r] : -1e30f;
#pragma unroll
        for (int i = 8; i < 10; ++i)
#pragma unroll
            for (int r = 0; r < 4; ++r) st[i][r] = (kk0 + 16 * i + r <= khi) ? st[i][r] : -1e30f;
        if (cu.n == 0) {
#pragma unroll
            for (int i = 2; i < 8; ++i)
#pragma unroll
                for (int r = 0; r < 4; ++r) st[i][r] = (kk0 + 16 * i + r >= klo) ? st[i][r] : -1e30f;
        }
        float mx = -1e30f;
#pragma unroll
        for (int i = 0; i < 10; ++i) mx = fmaxf(fmaxf(mx, fmaxf(st[i][0], st[i][1])), fmaxf(st[i][2], st[i][3]));
        mx = fmaxf(mx, __shfl_xor(mx, 16)); mx = fmaxf(mx, __shfl_xor(mx, 32));
        float l = 0.f;
#pragma unroll
        for (int i = 0; i < 10; ++i)
#pragma unroll
            for (int r = 0; r < 4; ++r) { const float p = __builtin_amdgcn_exp2f(st[i][r] - mx); st[i][r] = p; l += p; }
        l += __shfl_xor(l, 16); l += __shfl_xor(l, 32);
        bf16x8_t pb[5];
#pragma unroll
        for (int i2 = 0; i2 < 5; ++i2) { const pg8::u32x4 w = pg8::pack8(st[2 * i2], st[2 * i2 + 1]); pb[i2] = __builtin_bit_cast(bf16x8_t, w); }
        if (first) asm volatile("s_waitcnt vmcnt(12)" ::: "memory"); else asm volatile("s_waitcnt vmcnt(17)" ::: "memory");
        ATT_BAR();
        const int q4 = (lane >> 2) & 3, p4 = lane & 3, R0 = pi16(4 * fq + q4), fz = fswz(R0);
        const int vb0 = ATT_V_OFF + (kt0 * 16 + R0) * 256 + 8 * (p4 & 1);
        f32x4 o[8];
#pragma unroll
        for (int dt = 0; dt < 8; ++dt) {
            const int vb = vb0 + ((((2 * dt) ^ (fz & 14)) | ((p4 >> 1) ^ (fz & 1))) << 4);
            o[dt] = (f32x4){0.f, 0.f, 0.f, 0.f};
#pragma unroll
            for (int i2 = 0; i2 < 5; ++i2) {
                const s16x4 lo = __builtin_bit_cast(s16x4, __builtin_amdgcn_ds_read_tr16_b64_v4i16((LAS v4i16_t*)(F.lds + vb + (2 * i2) * 4096)));
                const s16x4 hi = __builtin_bit_cast(s16x4, __builtin_amdgcn_ds_read_tr16_b64_v4i16((LAS v4i16_t*)(F.lds + vb + (2 * i2 + 1) * 4096)));
                const bf16x8_t vf = __builtin_shufflevector(lo, hi, 0, 1, 2, 3, 4, 5, 6, 7);
                o[dt] = __builtin_amdgcn_mfma_f32_16x16x32_bf16(vf, pb[i2], o[dt], 0, 0, 0);
            }
        }
        asm volatile("s_waitcnt lgkmcnt(0)" ::: "memory");
        ATT_BAR();
        att_issue(F, Vb, cn, v3k, vch, ATT_V_OFF, wid);
        const float inv = 1.0f / l;
        bf16* orow = OP + ((size_t)cu.br * T + (size_t)cu.b * SEQ + tq) * AW + cu.h * HD + 4 * fq;
#pragma unroll
        for (int d2 = 0; d2 < 4; ++d2) {
            int x0 = (int)pg8::cvt_pk_bf16(o[2 * d2][0] * inv, o[2 * d2][1] * inv), x1 = (int)pg8::cvt_pk_bf16(o[2 * d2][2] * inv, o[2 * d2][3] * inv);
            int y0 = (int)pg8::cvt_pk_bf16(o[2 * d2 + 1][0] * inv, o[2 * d2 + 1][1] * inv), y1 = (int)pg8::cvt_pk_bf16(o[2 * d2 + 1][2] * inv, o[2 * d2 + 1][3] * inv);
            pg8::swap16(x0, y0); pg8::swap16(x1, y1);
            v4u w; w.x = (unsigned)x0; w.y = (unsigned)x1; w.z = (unsigned)y0; w.w = (unsigned)y1;
            *(v4u*)(orow + 16 * (2 * d2 + (fq & 1)) - 4 * (fq & 1)) = w; }
        { float* lp = LSE + ((size_t)cu.br * T + (size_t)cu.b * SEQ + tq) * NH + cu.h; const float lv = mx + __log2f(l); if (fq == 0) *lp = lv; }
        if (lastu) break;
        cu = cn; tq = tqn; ++ri;
    }
    asm volatile("s_waitcnt vmcnt(0)" ::: "memory");
    __syncthreads();
}
__device__ __forceinline__ void phase4_combine(Frame& F, const Args& a) {
    PHASE_IDS(F);
    const int gw = F.vcu * NWAVES + F.wave, NGW = F.G * NWAVES;
    const bf16* OP = (const bf16*)(a.ws + WS_OPART); const float* LSE = (const float*)(a.ws + WS_LSE); unsigned char* CAT8 = a.ws + WS_CAT;
    const bf16* GMO = (const bf16*)(a.ws + WS_GMO);
    for (int m = gw; m < T; m += NGW) {
        f32x4 r[4][2]; float am = 0.f, am2 = 0.f;
#pragma unroll
        for (int j = 0; j < 3; ++j) {
            const int ch = F.lane + 64 * j, hd = ch >> 4;
            const float l0 = LSE[((size_t)0 * T + m) * NH + hd], l1 = LSE[((size_t)1 * T + m) * NH + hd], l2 = LSE[((size_t)2 * T + m) * NH + hd];
            const float mx = fmaxf(l0, fmaxf(l1, l2)), e0 = __builtin_amdgcn_exp2f(l0 - mx), e1 = __builtin_amdgcn_exp2f(l1 - mx), e2 = __builtin_amdgcn_exp2f(l2 - mx), inv = 1.0f / (e0 + e1 + e2);
            const v4u a0 = *((const v4u*)(OP + ((size_t)0 * T + m) * AW) + ch), a1 = *((const v4u*)(OP + ((size_t)1 * T + m) * AW) + ch), a2 = *((const v4u*)(OP + ((size_t)2 * T + m) * AW) + ch);
            const float w0 = e0 * inv, w1 = e1 * inv, w2 = e2 * inv;
            r[j][0] = (f32x4){w0 * bflo(a0.x) + w1 * bflo(a1.x) + w2 * bflo(a2.x), w0 * bfhi(a0.x) + w1 * bfhi(a1.x) + w2 * bfhi(a2.x), w0 * bflo(a0.y) + w1 * bflo(a1.y) + w2 * bflo(a2.y), w0 * bfhi(a0.y) + w1 * bfhi(a1.y) + w2 * bfhi(a2.y)};
            r[j][1] = (f32x4){w0 * bflo(a0.z) + w1 * bflo(a1.z) + w2 * bflo(a2.z), w0 * bfhi(a0.z) + w1 * bfhi(a1.z) + w2 * bfhi(a2.z), w0 * bflo(a0.w) + w1 * bflo(a1.w) + w2 * bflo(a2.w), w0 * bfhi(a0.w) + w1 * bfhi(a1.w) + w2 * bfhi(a2.w)};
        }
        { const v4u gm = *((const v4u*)(GMO + (size_t)m * GW) + F.lane);
            r[3][0] = (f32x4){bflo(gm.x), bfhi(gm.x), bflo(gm.y), bfhi(gm.y)}; r[3][1] = (f32x4){bflo(gm.z), bfhi(gm.z), bflo(gm.w), bfhi(gm.w)}; }
#pragma unroll
        for (int j = 0; j < 3; ++j)
#pragma unroll
            for (int q = 0; q < 2; ++q) am = fmaxf(fmaxf(am, fmaxf(fabsf(r[j][q][0]), fabsf(r[j][q][1]))), fmaxf(fabsf(r[j][q][2]), fabsf(r[j][q][3])));
#pragma unroll
        for (int q = 0; q < 2; ++q) am2 = fmaxf(fmaxf(am2, fmaxf(fabsf(r[3][q][0]), fabsf(r[3][q][1]))), fmaxf(fabsf(r[3][q][2]), fabsf(r[3][q][3])));
        am = fmaxf(wave_max(am), 1e-20f); am2 = fmaxf(wave_max(am2), 1e-20f);
#pragma unroll
        for (int j = 0; j < 4; ++j) { const float qs = 127.0f / (j < 3 ? am : am2);
            v2u o; o.x = q8x4(r[j][0][0], r[j][0][1], r[j][0][2], r[j][0][3], qs); o.y = q8x4(r[j][1][0], r[j][1][1], r[j][1][2], r[j][1][3], qs);
            *((v2u*)(CAT8 + (size_t)m * D) + F.lane + 64 * j) = o; }
        if (F.lane == 0) { ((float*)(a.ws + WS_RSCAT))[m] = am2 * (1.0f / 127.0f); ((float*)(a.ws + WS_RSRATIO))[m] = fminf(am / am2, 1024.0f); }
    }
}

#define P5_BAR() asm volatile("s_waitcnt lgkmcnt(0)\n\ts_barrier" ::: "memory")
__device__ __forceinline__ void phase5(Frame& F, const Args& a) {
    PHASE_IDS(F);
    const float* mod = (const float*)(a.ws + WS_MOD); const bf16* Y1 = (const bf16*)(a.ws + WS_Y1); bf16* X1 = (bf16*)(a.ws + WS_X1);
    unsigned char* H8 = a.ws + WS_H8;
    int* TOPI = (int*)(a.ws + WS_TOPI); float* GATE = (float*)(a.ws + WS_GATE); int* RANK = (int*)(a.ws + WS_RANK);
    constexpr int HSB = D + 8;
    LAS unsigned short* hsh = (LAS unsigned short*)(F.lds);
    LAS unsigned short* hsl = (LAS unsigned short*)(F.lds + 8 * HSB * 2);
    LAS float* part = (LAS float*)(F.lds + 67584);
    LAS float* lgs = (LAS float*)(F.lds + 67584 + 16384);
    LAS int* hist = (LAS int*)(F.lds + 90112);
    LAS int* gbase = (LAS int*)(F.lds + 90112 + 128);
    LAS int* asg_e = (LAS int*)(F.lds + 91136);
    LAS int* asg_r = (LAS int*)(F.lds + 91136 + 4096);
    LAS int* asg_m = (LAS int*)(F.lds + 91136 + 8192);
    LAS float* prm = (LAS float*)(F.lds + 104448);
    const int lane = F.lane, wid = F.wave;
    if (F.tid < 32) hist[F.tid] = 0;
    const int rows_per_wg = T / F.G, row_base = F.vcu * rows_per_wg;
    { const float* mb0 = mod + (size_t)(row_base / SEQ) * (6 * D);
        for (int i = F.tid; i < D / 4; i += NWAVES * 64) { ((LAS f32x4*)prm)[i] = ((const f32x4*)a.ln1_g)[i]; ((LAS f32x4*)(prm + D))[i] = ((const f32x4*)a.ln1_b)[i];
            ((LAS f32x4*)(prm + 2 * D))[i] = ((const f32x4*)(mb0 + 3 * D))[i]; ((LAS f32x4*)(prm + 3 * D))[i] = ((const f32x4*)(mb0 + 4 * D))[i] + 1.0f; } }
    int li = 0;
    bf16x8_t wh[8][2], wl[8][2];
    { const float* wp = a.rw + (size_t)(wid * 256 + 8 * (lane >> 4)) * NE + (lane & 15);
#pragma unroll
        for (int sk = 0; sk < 8; ++sk)
#pragma unroll
            for (int nt = 0; nt < 2; ++nt) { float w8[8];
#pragma unroll
                for (int t = 0; t < 8; ++t) w8[t] = wp[(size_t)(32 * sk + t) * NE + 16 * nt];
                pg8::u32x4 hv, lv;
#pragma unroll
                for (int t2 = 0; t2 < 4; ++t2) { const unsigned h = pg8::cvt_pk_bf16(w8[2 * t2], w8[2 * t2 + 1]); hv[t2] = h; lv[t2] = pg8::cvt_pk_bf16(w8[2 * t2] - bflo(h), w8[2 * t2 + 1] - bfhi(h)); }
                wh[sk][nt] = __builtin_bit_cast(bf16x8_t, hv); wl[sk][nt] = __builtin_bit_cast(bf16x8_t, lv); } }
    const float rbv = a.rb[lane & 31];
    v2u ynx[8];
#pragma unroll
    for (int j = 0; j < 8; ++j) ynx[j] = *((const v2u*)(Y1 + (size_t)(row_base + wid) * D) + lane + 64 * j);
    P5_BAR();
    for (int sb = 0; sb < rows_per_wg; sb += 8, ++li) {
        const int m = row_base + sb + wid;
        {
            f32x4 v[8]; float s = 0.f;
#pragma unroll
            for (int j = 0; j < 8; ++j) { const v2u yw = ynx[j]; v[j] = (f32x4){bflo(yw.x), bfhi(yw.x), bflo(yw.y), bfhi(yw.y)}; s += (v[j].x + v[j].y) + (v[j].z + v[j].w); }
            float mean = wave_sum(s) * (1.f / D); float s2 = 0.f;
#pragma unroll
            for (int j = 0; j < 8; ++j) { v[j] = v[j] - mean; s2 += (v[j].x * v[j].x + v[j].y * v[j].y) + (v[j].z * v[j].z + v[j].w * v[j].w); }
            float rstd = 1.f / sqrtf(wave_sum(s2) * (1.f / D) + LN_EPS);
            v2u xw8[8];
            s = 0.f;
#pragma unroll
            for (int j = 0; j < 8; ++j) { if ((j & 3) == 0) asm volatile("" ::: "memory"); const f32x4 gg = *((const LAS f32x4*)prm + lane + 64 * j), bb = *((const LAS f32x4*)(prm + D) + lane + 64 * j);
                v[j] = v[j] * rstd * gg + bb; xw8[j].x = pk2(v[j].x, v[j].y); xw8[j].y = pk2(v[j].z, v[j].w); s += (v[j].x + v[j].y) + (v[j].z + v[j].w); }
            store_row_b8<8, 512>((unsigned char*)(X1 + (size_t)m * D), lane, xw8);
            mean = wave_sum(s) * (1.f / D); s2 = 0.f;
#pragma unroll
            for (int j = 0; j < 8; ++j) { v[j] = v[j] - mean; s2 += (v[j].x * v[j].x + v[j].y * v[j].y) + (v[j].z * v[j].z + v[j].w * v[j].w); }
            rstd = 1.f / sqrtf(wave_sum(s2) * (1.f / D) + LN_EPS);
            unsigned* o4 = (unsigned*)(H8 + (size_t)m * D) + lane; float am = 0.f;
#pragma unroll
            for (int j = 0; j < 8; ++j) { if ((j & 3) == 0) asm volatile("" ::: "memory"); const f32x4 sh = *((const LAS f32x4*)(prm + 2 * D) + lane + 64 * j), sc1 = *((const LAS f32x4*)(prm + 3 * D) + lane + 64 * j);
                v[j] = v[j] * rstd * sc1 + sh; am = fmaxf(fmaxf(am, fmaxf(fabsf(v[j].x), fabsf(v[j].y))), fmaxf(fabsf(v[j].z), fabsf(v[j].w)));
                { const unsigned h0 = pg8::cvt_pk_bf16(v[j].x, v[j].y), h1 = pg8::cvt_pk_bf16(v[j].z, v[j].w);
                  v2u hv; hv.x = h0; hv.y = h1; v2u lv; lv.x = pg8::cvt_pk_bf16(v[j].x - bflo(h0), v[j].y - bfhi(h0)); lv.y = pg8::cvt_pk_bf16(v[j].z - bflo(h1), v[j].w - bfhi(h1));
                  *((LAS v2u*)(hsh + wid * HSB) + lane + 64 * j) = hv; *((LAS v2u*)(hsl + wid * HSB) + lane + 64 * j) = lv; } }
            am = fmaxf(wave_max(am), 1e-20f);
            const float qs = 127.0f / am;
            { unsigned hw[8];
#pragma unroll
              for (int j = 0; j < 8; ++j) hw[j] = q8x4(v[j].x, v[j].y, v[j].z, v[j].w, qs);
              store_row_b4(H8 + (size_t)m * D, lane, hw); }
            if (lane == 0) ((float*)(a.ws + WS_RSH2))[m] = am * (1.0f / 127.0f);
        }
        LDS_WAIT();
        P5_BAR();
        {
            const int q = lane >> 4, j = lane & 15;
            f32x4 acc0 = (f32x4){0.f, 0.f, 0.f, 0.f}, acc1 = (f32x4){0.f, 0.f, 0.f, 0.f};
            const int aoff = (lane & 7) * HSB + wid * 256 + 8 * q;
#pragma unroll
            for (int sk = 0; sk < 8; ++sk) { const bf16x8_t ah = *(const LAS bf16x8_t*)(hsh + aoff + 32 * sk), al = *(const LAS bf16x8_t*)(hsl + aoff + 32 * sk);
                acc0 = __builtin_amdgcn_mfma_f32_16x16x32_bf16(ah, wh[sk][0], acc0, 0, 0, 0); acc1 = __builtin_amdgcn_mfma_f32_16x16x32_bf16(ah, wh[sk][1], acc1, 0, 0, 0);
                acc0 = __builtin_amdgcn_mfma_f32_16x16x32_bf16(ah, wl[sk][0], acc0, 0, 0, 0); acc1 = __builtin_amdgcn_mfma_f32_16x16x32_bf16(ah, wl[sk][1], acc1, 0, 0, 0);
                acc0 = __builtin_amdgcn_mfma_f32_16x16x32_bf16(al, wh[sk][0], acc0, 0, 0, 0); acc1 = __builtin_amdgcn_mfma_f32_16x16x32_bf16(al, wh[sk][1], acc1, 0, 0, 0); }
            if (q < 2) {
#pragma unroll
                for (int r = 0; r < 4; ++r) { part[(wid * 8 + 4 * q + r) * 32 + j] = acc0[r]; part[(wid * 8 + 4 * q + r) * 32 + 16 + j] = acc1[r]; } }
        }
        if (sb + 8 < rows_per_wg) {
#pragma unroll
            for (int j = 0; j < 8; ++j) ynx[j] = *((const v2u*)(Y1 + (size_t)(m + 8) * D) + lane + 64 * j);
        }
        LDS_WAIT();
        P5_BAR();
        {
            float lv = rbv;
#pragma unroll
            for (int k = 0; k < 8; ++k) lv += part[(k * 8 + wid) * 32 + (lane & 31)];
            float tv[4]; int ti[4];
#pragma unroll
            for (int k = 0; k < 4; ++k) {
                float v = lv;
                v = fmaxf(v, __builtin_bit_cast(float, __builtin_amdgcn_mov_dpp(__builtin_bit_cast(int, v), 0xB1, 0xF, 0xF, true)));
                v = fmaxf(v, __builtin_bit_cast(float, __builtin_amdgcn_mov_dpp(__builtin_bit_cast(int, v), 0x4E, 0xF, 0xF, true)));
                v = fmaxf(v, __builtin_bit_cast(float, __builtin_amdgcn_mov_dpp(__builtin_bit_cast(int, v), 0x141, 0xF, 0xF, true)));
                v = fmaxf(v, __builtin_bit_cast(float, __builtin_amdgcn_mov_dpp(__builtin_bit_cast(int, v), 0x140, 0xF, 0xF, true)));
                const float best = fmaxf(__builtin_bit_cast(float, __builtin_amdgcn_readlane(__builtin_bit_cast(int, v), 0)), __builtin_bit_cast(float, __builtin_amdgcn_readlane(__builtin_bit_cast(int, v), 16)));
                const unsigned long long bal = __builtin_amdgcn_ballot_w64(lv == best);
                const int bi = (int)__builtin_ctzll(bal) & 31;
                tv[k] = best; ti[k] = bi;
                lv = ((lane & 31) == bi) ? -3.0e38f : lv; }
            const float e1 = __expf(tv[1] - tv[0]), e2 = __expf(tv[2] - tv[0]), e3 = __expf(tv[3] - tv[0]), inv = 1.0f / (1.0f + e1 + e2 + e3);
            if (lane < 4) {
                const int k = lane; const int e = k == 0 ? ti[0] : k == 1 ? ti[1] : k == 2 ? ti[2] : ti[3];
                const float gt = (k == 0 ? 1.0f : k == 1 ? e1 : k == 2 ? e2 : e3) * inv;
                TOPI[m * 4 + k] = e; GATE[m * 4 + k] = gt;
                const int lr = __hip_atomic_fetch_add(&hist[e], 1, __ATOMIC_RELAXED, __HIP_MEMORY_SCOPE_WORKGROUP);
                const int idx = (li * NWAVES + wid) * 4 + k;
                asg_e[idx] = e; asg_r[idx] = lr; asg_m[idx] = m * 4 + k;
            }
        }
    }
    __syncthreads();
    if (F.tid < 32) gbase[F.tid] = (int)__hip_atomic_fetch_add(F.ctl + CW_CNT + F.tid * CW_CNT_STRIDE, (unsigned)hist[F.tid], RLX_AGENT);
    __syncthreads();
    const int nasg = li * NWAVES * 4;
    for (int i = F.tid; i < nasg; i += NWAVES * 64) RANK[asg_m[i]] = gbase[asg_e[i]] + asg_r[i];
    __syncthreads();
}

__device__ __forceinline__ void phase6(Frame& F, const Args& a) {
    PHASE_IDS(F);
    LAS int* tb = (LAS int*)(F.lds);
    LAS int* cn = (LAS int*)(F.lds + 256);
    const int* TOPI = (const int*)(a.ws + WS_TOPI); const int* RANK = (const int*)(a.ws + WS_RANK);
    int* TSLOT = (int*)(a.ws + WS_TSLOT); int* TILEE = (int*)(a.ws + WS_TILEE);
    if (F.tid < 32) cn[F.tid] = (int)__hip_atomic_load(F.ctl + CW_CNT + F.tid * CW_CNT_STRIDE, RLX_AGENT);
    __syncthreads();
    if (F.tid == 0) { int acc = 0; for (int e = 0; e < 32; ++e) { tb[e] = acc; acc += (cn[e] + 255) >> 8; } tb[32] = acc; }
    __syncthreads();
    if (blockIdx.x == 0) {
        if (F.tid < 32) { const int e = F.tid; for (int i = tb[e]; i < tb[e + 1]; ++i) TILEE[i] = e; }
        if (F.tid == 0) TILEE[512] = tb[32];
    }
    int* SLOTTOK = (int*)(a.ws + WS_SLOTTOK); float* RSSLOT = (float*)(a.ws + WS_RSSLOT); const float* RSH2 = (const float*)(a.ws + WS_RSH2);
    if (blockIdx.x < 32) { const int e = blockIdx.x; for (int s_ = cn[e] + F.tid; s_ < ((tb[e + 1] - tb[e]) << 8); s_ += NWAVES * 64) { SLOTTOK[(tb[e] << 8) + s_] = 0; RSSLOT[(tb[e] << 8) + s_] = RSH2[0]; } }
    for (int i = blockIdx.x * (NWAVES * 64) + F.tid; i < T * TOPK; i += F.G * NWAVES * 64) {
        const int e = TOPI[i], slot = (tb[e] << 8) + RANK[i];
        SLOTTOK[slot] = i >> 2; TSLOT[i] = slot; RSSLOT[slot] = RSH2[i >> 2];
    }
    __syncthreads();
}

__device__ __forceinline__ void phase9(Frame& F, const Args& a) {
    PHASE_IDS(F);
    const int gw = F.vcu * NWAVES + F.wave, NGW = F.G * NWAVES;
    const float* mod = (const float*)(a.ws + WS_MOD); const unsigned char* YS = (const unsigned char*)(a.ws + WS_YS);
    const int* TSLOT = (const int*)(a.ws + WS_TSLOT); const float* GATE = (const float*)(a.ws + WS_GATE); const bf16* X1 = (const bf16*)(a.ws + WS_X1);
    LAS float* prm = (LAS float*)(F.lds);
    for (int i = F.tid; i < D / 4; i += NWAVES * 64) { ((LAS f32x4*)prm)[i] = ((const f32x4*)a.ln2_g)[i]; ((LAS f32x4*)(prm + D))[i] = ((const f32x4*)a.ln2_b)[i];
#pragma unroll
        for (int b = 0; b < BATCH; ++b) ((LAS f32x4*)(prm + (2 + b) * D))[i] = ((const f32x4*)(mod + (size_t)b * (6 * D) + 5 * D))[i]; }
    __syncthreads();
    int sln[4] = {0, 0, 0, 0}; float gtn[4] = {0.f, 0.f, 0.f, 0.f};
    if (gw < T) {
#pragma unroll
        for (int k = 0; k < 4; ++k) { sln[k] = TSLOT[gw * 4 + k]; gtn[k] = GATE[gw * 4 + k]; } }
    for (int m = gw; m < T; m += NGW) {
        f32x4* xo = (f32x4*)(a.out + (size_t)m * D) + F.lane; const v2u* xi = (const v2u*)(X1 + (size_t)m * D) + F.lane;
        const LAS float* mb = prm + (2 + m / SEQ) * D;
        int sl[4]; float gt[4];
#pragma unroll
        for (int k = 0; k < 4; ++k) { sl[k] = sln[k]; gt[k] = gtn[k] * (1.0f / SC_YS); }
        if (m + NGW < T) {
#pragma unroll
            for (int k = 0; k < 4; ++k) { sln[k] = TSLOT[(m + NGW) * 4 + k]; gtn[k] = GATE[(m + NGW) * 4 + k]; } }
        f32x4 v[8]; float s = 0.f;
#pragma unroll
        for (int j = 0; j < 8; ++j) {
            f32x4 f = (f32x4){0.f, 0.f, 0.f, 0.f};
#pragma unroll
            for (int k = 0; k < 4; ++k) { const int w = *((const int*)(YS + (size_t)sl[k] * D) + F.lane + 64 * j);
                const auto lo = __builtin_amdgcn_cvt_pk_f32_fp8(w, false), hi = __builtin_amdgcn_cvt_pk_f32_fp8(w, true);
                f += (f32x4){lo[0], lo[1], hi[0], hi[1]} * gt[k]; }
            const f32x4 g2 = *((const LAS f32x4*)mb + F.lane + 64 * j);
            const v2u xw = xi[64 * j];
            v[j] = (f32x4){bflo(xw.x), bfhi(xw.x), bflo(xw.y), bfhi(xw.y)} * DN_ALPHA + g2 * f; s += (v[j].x + v[j].y) + (v[j].z + v[j].w); }
        const float mean = wave_sum(s) * (1.f / D); float s2 = 0.f;
#pragma unroll
        for (int j = 0; j < 8; ++j) { v[j] = v[j] - mean; s2 += (v[j].x * v[j].x + v[j].y * v[j].y) + (v[j].z * v[j].z + v[j].w * v[j].w); }
        const float rstd = 1.f / sqrtf(wave_sum(s2) * (1.f / D) + LN_EPS);
#pragma unroll
        for (int j = 0; j < 8; ++j) { const f32x4 gg = *((const LAS f32x4*)prm + F.lane + 64 * j), bb = *((const LAS f32x4*)(prm + D) + F.lane + 64 * j);
            xo[64 * j] = v[j] * rstd * gg + bb; }
    }
}

__global__ void __launch_bounds__(NWAVES * 64, 2) fwd_kernel(Args args) {
    extern __shared__ __attribute__((aligned(16))) unsigned char lds[];
    Frame F;
    F.lds = (LAS unsigned char*)lds;
    F.MISC = (volatile LAS unsigned*)(F.lds + MISC_OFF);
    F.tid = threadIdx.x; F.lane = F.tid & 63; F.wave = __builtin_amdgcn_readfirstlane(F.tid >> 6);
    F.G = gridDim.x; { const int bx = blockIdx.x; F.vcu = (F.G % 8 == 0) ? (bx % 8) * (F.G / 8) + bx / 8 : bx; }
    unsigned char* ws = args.ws;
    F.ctl = (unsigned*)(ws + WS_CTL);
    for (int u = F.tid; u < (LDS_BYTES - LDSCTL_OFF) / 4; u += NWAVES * 64) ((LAS unsigned*)(F.lds + LDSCTL_OFF))[u] = 0u;
    __syncthreads();
    XcdBarrier bar; bar.bar = F.ctl + CW_BAR; bar.x = 0; bar.st = nullptr;
    if (N_LAUNCHES != PER_PHASE) bar = xcd_barrier_post(F.ctl + CW_BAR, F.MISC + 8);
#define GRID_BAR() do { if (N_LAUNCHES != PER_PHASE) xcd_barrier(bar); } while (0)
    const int lo = args.ph_lo, hi = args.ph_hi;
#define IN(k) (lo <= (k) && (k) < hi)
#define BOTH(k) (IN(k) && IN((k) + 1))

    if (IN(0)) { phase0(F, args); if (BOTH(0)) GRID_BAR(); }
    if (IN(1)) { phase1(F, args); if (BOTH(1)) GRID_BAR(); }
    if (IN(2)) {
        pg8::Gemm g{ws + WS_H, ws + WS_WIN, D, 0, nullptr, (const float*)(ws + WS_RSH)};
        pg8::Order S; S.init(T / 256, NPROJ / 256, F.G, (int)blockIdx.x, nullptr, WGM_IN);
        static_assert(WS_K - WS_Q == (48u << 20) && WS_V - WS_K == (48u << 20) && WS_VG - WS_U == (16u << 20), "EpiInProj strides");
        pg8::EpiInProj E{ws, WS_Q, WS_U, (const _Float16*)(ws + WS_ROPE), 1.0f / SC_WIN};
        const bool conv_first = (blockIdx.x & 8) != 0;
        if (conv_first) conv_dyn(F, args, CONV_NCHUNK / 2);
        pg8::gemm_phase<pg8::EpiInProj, false, 2>(F.lds + RING_OFF, g, S, E);
        conv_dyn(F, args, CONV_NCHUNK);
        if (BOTH(2)) GRID_BAR();
    }
    if (IN(3)) { phase3_gmlp(F, args); phase3_attn(F, args); if (BOTH(3)) GRID_BAR(); }
    if (IN(4)) { phase4_combine(F, args); if (BOTH(4)) GRID_BAR(); }
    if (IN(5)) {
        pg8::Gemm g{ws + WS_CAT, ws + WS_WOUT, D, 0, nullptr, (const float*)(ws + WS_RSCAT), (const float*)(ws + WS_RSRATIO), AW / 128};
        pg8::Order S; S.init(T / 256, D / 256, F.G, (int)blockIdx.x, nullptr, WGM_OUT);
        pg8::EpiOutProj E{args.x, (const float*)(ws + WS_MOD), (bf16*)(ws + WS_Y1), 1.0f / SC_WOUT};
        pg8::gemm_phase<pg8::EpiOutProj, false, 2, true>(F.lds + RING_OFF, g, S, E);
        if (BOTH(5)) GRID_BAR();
    }
    if (IN(6)) { phase5(F, args); if (BOTH(6)) GRID_BAR(); }
    if (IN(7)) { phase6(F, args); if (BOTH(7)) GRID_BAR(); }
    if (IN(8)) {
        const int* TILEE = (const int*)(ws + WS_TILEE);
        const int ntiles = __builtin_amdgcn_readfirstlane(TILEE[512]);
        pg8::Gemm g{ws + WS_H8, ws + WS_WGU, D, (size_t)2 * DFF * D, (const int*)(ws + WS_SLOTTOK), (const float*)(ws + WS_RSSLOT)};
        pg8::Order S; S.init(ntiles, 2 * DFF / 256, F.G, (int)blockIdx.x, TILEE, WGM_GU);
        pg8::EpiSwiglu E{args.bgu, ws + WS_ACT, 1.0f / SC_WGU, SC_ACT};
        pg8::gemm_phase<pg8::EpiSwiglu, true, 2>(F.lds + RING_OFF, g, S, E);
        if (BOTH(8)) GRID_BAR();
    }
    if (IN(9)) {
        const int* TILEE = (const int*)(ws + WS_TILEE);
        const int ntiles = __builtin_amdgcn_readfirstlane(TILEE[512]);
        pg8::Gemm g{ws + WS_ACT, ws + WS_WD, DFF, (size_t)D * DFF, nullptr};
        pg8::Order S; S.init(ntiles, D / 256, F.G, (int)blockIdx.x, TILEE, WGM_DN);
        pg8::EpiDown E{args.bd, ws + WS_YS, 1.0f / (SC_ACT * SC_WD), SC_YS};
        pg8::gemm_phase<pg8::EpiDown, false, true>(F.lds + RING_OFF, g, S, E);
        if (BOTH(9)) GRID_BAR();
    }
    if (IN(10)) { phase9(F, args); }
#undef IN
#undef BOTH
}

extern "C" void kernel_launch(void* const* d_in, const int* in_sizes, int n_in, void* d_out, int out_size, void* d_ws, size_t ws_size, hipStream_t stream) {
    static int grid = 0;
    if (grid == 0) {
        if (n_in != 21 || in_sizes[0] != T * D || out_size != T * D || ws_size < WS_END) { fprintf(stderr, "kernel_launch: unexpected shapes (n_in %d, ws %zu)\n", n_in, ws_size); grid = -1; return; }
        if (hipFuncSetAttribute((const void*)fwd_kernel, hipFuncAttributeMaxDynamicSharedMemorySize, LDS_BYTES) != hipSuccess) { fprintf(stderr, "kernel_launch: hipFuncSetAttribute failed\n"); grid = -1; return; }
        int per_cu = 0;
        if (hipOccupancyMaxActiveBlocksPerMultiprocessor(&per_cu, (const void*)fwd_kernel, NWAVES * 64, LDS_BYTES) != hipSuccess || per_cu < 1) fprintf(stderr, "kernel_launch: occupancy query says %d\n", per_cu);
        (void)hipGetLastError();
        grid = 256;
    }
    if (grid < 0) return;
    if (hipMemsetAsync((char*)d_ws + WS_CTL, 0, CTL_ZERO_BYTES, stream) != hipSuccess) return;
    Args a{};
    a.x = (const float*)d_in[0]; a.c = (const float*)d_in[1]; a.pos = (const int*)d_in[2]; a.ada_w = (const float*)d_in[3]; a.ada_b = (const float*)d_in[4];
    a.w_in = (const float*)d_in[5]; a.w_sp = (const float*)d_in[6]; a.b_sp = (const float*)d_in[7]; a.gln_g = (const float*)d_in[8]; a.gln_b = (const float*)d_in[9];
    a.w_out = (const float*)d_in[10]; a.ln1_g = (const float*)d_in[11]; a.ln1_b = (const float*)d_in[12]; a.rw = (const float*)d_in[13]; a.rb = (const float*)d_in[14];
    a.wgu = (const float*)d_in[15]; a.bgu = (const float*)d_in[16]; a.wd = (const float*)d_in[17]; a.bd = (const float*)d_in[18]; a.ln2_g = (const float*)d_in[19]; a.ln2_b = (const float*)d_in[20];
    a.out = (float*)d_out; a.ws = (unsigned char*)d_ws;
    if (N_LAUNCHES == 1) { a.ph_lo = 0; a.ph_hi = PER_PHASE; hipLaunchKernelGGL(fwd_kernel, dim3(grid), dim3(NWAVES * 64), LDS_BYTES, stream, a); }
    else for (int p = 0; p < PER_PHASE; ++p) { a.ph_lo = p; a.ph_hi = p + 1; hipLaunchKernelGGL(fwd_kernel, dim3(grid), dim3(NWAVES * 64), LDS_BYTES, stream, a); }
}
```
